# Optimizing an MI355X kernel written in HIP

```python
import jax, jax.numpy as jnp
from jax import lax
import numpy as np

D_MODEL = 1024
BATCH = 2
SEQ = 8192
DEPTH = 4

GRID_W = 64
CTX_LEN = 256
N_MIXERS = 2
N_A = (DEPTH + 1) // 2
N_B = DEPTH // 2
N_MOD = 9
D_FF = 2816
EPS = 1e-6
A_HEADS = 4
A_INNER = 2 * D_MODEL
A_HEAD_DIM = A_INNER // A_HEADS
A_QKV_BLOCK = 4
A_CHUNK = 64
A_CONV = 3
B_CHUNK = 128
B_HALF = 3 * D_MODEL
B_GROUPS = 8

kernel_name = "hybrid_mlstm_gmlp_dit_trunk"


def rmsnorm(x, g):
    xf = x.astype(jnp.float32)
    y = xf * lax.rsqrt(jnp.mean(xf * xf, axis=-1, keepdims=True) + EPS)
    return (y * g.astype(jnp.float32)).astype(x.dtype)


def layernorm(x, g, b):
    xf = x.astype(jnp.float32)
    mu = jnp.mean(xf, axis=-1, keepdims=True)
    var = jnp.mean(jnp.square(xf - mu), axis=-1, keepdims=True)
    y = (xf - mu) * lax.rsqrt(var + EPS)
    return (y * g.astype(jnp.float32) + b.astype(jnp.float32)).astype(x.dtype)


def adaln(cond, w, b):
    mod = jax.nn.silu(cond) @ w + b
    return jnp.split(mod[..., None, :], N_MOD, axis=-1)


def modulate(h, g, shift, scale):
    return rmsnorm(h, g) * (1 + scale) + shift


def residual(h, y, g, gate, weight):
    return h + weight * gate * rmsnorm(y, g)


def swiglu(t, w_in, w_out):
    gate, up = jnp.split(t @ w_in, 2, axis=-1)
    return (jax.nn.silu(gate) * up) @ w_out


def dwconv2d(t, w, bias, rows, cols):
    B, T, Ch = t.shape
    img = t.reshape(B, rows, cols, Ch)
    out = lax.conv_general_dilated(img, w[:, :, None, :], (1, 1), 'SAME',
                                   dimension_numbers=('NHWC', 'HWIO', 'NHWC'),
                                   feature_group_count=Ch)
    return out.reshape(B, T, Ch) + bias


def blockdiag(t, w):
    B, T, _ = t.shape
    return jnp.einsum('btni,noi->btno', t.reshape(B, T, w.shape[0], w.shape[2]), w).reshape(B, T, -1)


def mlstm_scan(q, k, v, ig, lf, state):
    B, H, T, DH = q.shape
    nc = T // A_CHUNK

    def chunks(a):
        return jnp.moveaxis(a.reshape(B, H, nc, A_CHUNK, *a.shape[3:]), 2, 0)

    tril = jnp.tril(jnp.ones((A_CHUNK, A_CHUNK), dtype=bool))

    def step(carry, xs):
        C, n, m = carry
        qc, kc, vc, ic, fc = xs
        b = jnp.cumsum(fc, axis=-1)
        log_d = jnp.where(tril, b[..., :, None] - b[..., None, :] + ic[..., None, :], -jnp.inf)
        m_inter = b + m[..., None]
        m_t = jnp.maximum(m_inter, jnp.max(log_d, axis=-1))
        s = jnp.einsum('bhtd,bhsd->bhts', qc, kc) * jnp.exp(log_d - m_t[..., None])
        scale_inter = jnp.exp(m_inter - m_t)
        num = jnp.einsum('bhts,bhsd->bhtd', s, vc) + scale_inter[..., None] * jnp.einsum('bhvk,bhtk->bhtv', C, qc)
        den = jnp.sum(s, axis=-1) + scale_inter * jnp.einsum('bhk,bhtk->bht', n, qc)
        h = num / jnp.maximum(jnp.abs(den), jnp.exp(-m_t))[..., None]
        b_last = b[..., -1]
        log_w = b_last[..., None] - b + ic
        m_new = jnp.maximum(b_last + m, jnp.max(log_w, axis=-1))
        w = jnp.exp(log_w - m_new[..., None])
        decay = jnp.exp(b_last + m - m_new)
        C_new = decay[..., None, None] * C + jnp.einsum('bhsv,bhsk->bhvk', w[..., None] * vc, kc)
        n_new = decay[..., None] * n + jnp.einsum('bhs,bhsk->bhk', w, kc)
        return (C_new, n_new, m_new), h

    state, hs = lax.scan(step, state, (chunks(q), chunks(k), chunks(v), chunks(ig), chunks(lf)))
    return jnp.moveaxis(hs, 0, 2).reshape(B, H, T, DH), state


def mlstm_inputs(t, rows, cols, w_in, conv_w, conv_b, w_qkv, w_gates, b_gates):
    B, T, _ = t.shape
    xm, z = jnp.split(t @ w_in, 2, axis=-1)
    xc = jax.nn.silu(dwconv2d(xm, conv_w, conv_b, rows, cols))
    q = blockdiag(xc, w_qkv[0])
    k = blockdiag(xc, w_qkv[1])
    v = blockdiag(xm, w_qkv[2])
    gates = jnp.concatenate([q, k, v], axis=-1) @ w_gates + b_gates
    g = jnp.transpose(gates.astype(jnp.float32).reshape(B, T, 4, A_HEADS), (2, 0, 3, 1))

    def heads(a):
        return a.reshape(B, T, A_HEADS, A_HEAD_DIM).transpose(0, 2, 1, 3).astype(jnp.float32)

    qkv = (heads(q), heads(k) * (A_HEAD_DIM ** -0.5), heads(v))
    fwd = qkv + (g[0], jax.nn.log_sigmoid(g[1]))
    bwd = tuple(jnp.flip(a, axis=2) for a in qkv + (g[2], jax.nn.log_sigmoid(g[3])))
    return fwd, bwd, xc, z


def mlstm_output(h, xc, z, norm_g, skip, w_out):
    B, H, T, DH = h.shape
    mu = jnp.mean(h, axis=-1, keepdims=True)
    var = jnp.mean(jnp.square(h - mu), axis=-1, keepdims=True)
    hn = ((h - mu) * lax.rsqrt(var + EPS)).transpose(0, 2, 1, 3).reshape(B, T, H * DH)
    hn = (hn * norm_g.astype(jnp.float32)).astype(xc.dtype)
    return ((hn + skip * xc) * jax.nn.silu(z)) @ w_out


def mlstm_mixer(xn, cn, rows, w_in, conv_w, conv_b, w_qkv, w_gates, b_gates, norm_g, skip, w_out, ctx_out):
    B = xn.shape[0]
    fx, bx, xcx, zx = mlstm_inputs(xn, rows, GRID_W, w_in, conv_w, conv_b, w_qkv, w_gates, b_gates)
    fc, bc, xcc, zc = mlstm_inputs(cn, 1, cn.shape[1], w_in, conv_w, conv_b, w_qkv, w_gates, b_gates)
    zero = (jnp.zeros((B, A_HEADS, A_HEAD_DIM, A_HEAD_DIM), jnp.float32),
            jnp.zeros((B, A_HEADS, A_HEAD_DIM), jnp.float32),
            jnp.zeros((B, A_HEADS), jnp.float32))
    h_cf, s_f = mlstm_scan(*fc, zero)
    h_cb, s_b = mlstm_scan(*bc, zero)
    h_xf, _ = mlstm_scan(*fx, s_f)
    h_xb, _ = mlstm_scan(*bx, s_b)
    y_x = mlstm_output(h_xf + jnp.flip(h_xb, axis=2), xcx, zx, norm_g, skip, w_out).astype(xn.dtype)
    y_c = None
    if ctx_out:
        y_c = mlstm_output(h_cf + jnp.flip(h_cb, axis=2), xcc, zc, norm_g, skip, w_out).astype(cn.dtype)
    return y_x, y_c


def gmlp(t, w_in, b_in, ln_g, ln_b, w_s, b_s, w_out, b_out):
    B, T, _ = t.shape
    u, v = jnp.split(jax.nn.gelu(t @ w_in + b_in, approximate=False), 2, axis=-1)
    v = layernorm(v, ln_g, ln_b)
    vb = v.reshape(B, T // B_CHUNK, B_CHUNK, B_GROUPS, B_HALF // B_GROUPS)
    vb = jnp.einsum('gpq,bnqge->bnpge', w_s, vb) + b_s.T[None, None, :, :, None]
    return (u * vb.reshape(B, T, B_HALF)) @ w_out + b_out


def setup_inputs(seed: int = 0) -> dict:
    key = jax.random.key(seed)
    ks = jax.random.split(key, 32)

    def nrm(k, shape, scale):
        return jax.random.normal(k, shape, jnp.float32) * scale

    D, DI, E, H = D_MODEL, A_INNER, B_HALF, A_HEADS
    gate_base = jnp.concatenate([jnp.zeros((H,), jnp.float32), jnp.linspace(3.0, 6.0, H, dtype=jnp.float32),
                                 jnp.zeros((H,), jnp.float32), jnp.linspace(3.0, 6.0, H, dtype=jnp.float32)])
    return {
        "x": nrm(ks[0], (BATCH, SEQ, D), 1.0),
        "c": nrm(ks[1], (BATCH, D), 1.0),
        "ctx": nrm(ks[2], (BATCH, CTX_LEN, D), 1.0),
        "c_ctx": nrm(ks[3], (D,), 1.0),
        "w_ada": nrm(ks[4], (DEPTH, D, N_MOD * D), 0.5 * D ** -0.5),
        "b_ada": nrm(ks[5], (DEPTH, N_MOD * D), 0.02),
        "norm_g": 1.0 + nrm(ks[6], (DEPTH, 6, D), 0.05),
        "ffn_w_in": nrm(ks[7], (DEPTH, 2, D, 2 * D_FF), D ** -0.5),
        "ffn_w_out": nrm(ks[8], (DEPTH, 2, D_FF, D), D_FF ** -0.5),
        "a_w_in": nrm(ks[9], (N_A, D, 2 * DI), D ** -0.5),
        "a_conv_w": nrm(ks[10], (N_A, A_CONV, A_CONV, DI), 1.0 / A_CONV),
        "a_conv_b": nrm(ks[11], (N_A, DI), 0.02),
        "a_w_qkv": nrm(ks[12], (N_A, 3, DI // A_QKV_BLOCK, A_QKV_BLOCK, A_QKV_BLOCK), A_QKV_BLOCK ** -0.5),
        "a_w_gates": nrm(ks[13], (N_A, 3 * DI, 4 * H), 0.5 * (3 * DI) ** -0.5),
        "a_b_gates": gate_base[None, :] + nrm(ks[14], (N_A, 4 * H), 0.1),
        "a_norm_g": 1.0 + nrm(ks[15], (N_A, DI), 0.05),
        "a_skip": 1.0 + nrm(ks[16], (N_A, DI), 0.05),
        "a_w_out": nrm(ks[17], (N_A, DI, D), DI ** -0.5),
        "b_w_in": nrm(ks[18], (N_B, D, 2 * E), D ** -0.5),
        "b_b_in": nrm(ks[19], (N_B, 2 * E), 0.02),
        "b_ln_g": 1.0 + nrm(ks[20], (N_B, E), 0.05),
        "b_ln_b": nrm(ks[21], (N_B, E), 0.02),
        "b_w_s": nrm(ks[22], (N_B, B_GROUPS, B_CHUNK, B_CHUNK), B_CHUNK ** -0.5),
        "b_b_s": 1.0 + nrm(ks[23], (N_B, B_GROUPS, B_CHUNK), 0.05),
        "b_w_out": nrm(ks[24], (N_B, E, D), E ** -0.5),
        "b_b_out": nrm(ks[25], (N_B, D), 0.02),
    }


def reference(x, c, ctx, c_ctx, w_ada, b_ada, norm_g, ffn_w_in, ffn_w_out,
              a_w_in, a_conv_w, a_conv_b, a_w_qkv, a_w_gates, a_b_gates, a_norm_g, a_skip, a_w_out,
              b_w_in, b_b_in, b_ln_g, b_ln_b, b_w_s, b_b_s, b_w_out, b_b_out):
    rows = x.shape[1] // GRID_W
    a_layers = [j for j in range(DEPTH) if j % N_MIXERS == 0]
    for i in range(DEPTH):
        kind = i % N_MIXERS
        li = i // N_MIXERS
        need_in = any(j >= i for j in a_layers)
        need_out = any(j > i for j in a_layers)
        mx = adaln(c, w_ada[i], b_ada[i])
        mc = adaln(c_ctx[None], w_ada[i], b_ada[i])
        ng = norm_g[i]
        x = residual(x, swiglu(modulate(x, ng[0], mx[0], mx[1]), ffn_w_in[i, 0], ffn_w_out[i, 0]), ng[1], mx[2], 0.5)
        cn = None
        if need_in:
            ctx = residual(ctx, swiglu(modulate(ctx, ng[0], mc[0], mc[1]), ffn_w_in[i, 0], ffn_w_out[i, 0]), ng[1], mc[2], 0.5)
            cn = modulate(ctx, ng[2], mc[3], mc[4])
        xn = modulate(x, ng[2], mx[3], mx[4])
        if kind == 0:
            y_x, y_c = mlstm_mixer(xn, cn, rows, a_w_in[li], a_conv_w[li], a_conv_b[li], a_w_qkv[li],
                                   a_w_gates[li], a_b_gates[li], a_norm_g[li], a_skip[li], a_w_out[li], need_out)
        else:
            y_x = gmlp(xn, b_w_in[li], b_b_in[li], b_ln_g[li], b_ln_b[li], b_w_s[li], b_b_s[li], b_w_out[li], b_b_out[li])
            y_c = None
            if need_out:
                y_c = gmlp(cn, b_w_in[li], b_b_in[li], b_ln_g[li], b_ln_b[li], b_w_s[li], b_b_s[li], b_w_out[li], b_b_out[li])
        x = residual(x, y_x, ng[3], mx[5], 1.0)
        x = residual(x, swiglu(modulate(x, ng[4], mx[6], mx[7]), ffn_w_in[i, 1], ffn_w_out[i, 1]), ng[5], mx[8], 0.5)
        if need_out:
            ctx = residual(ctx, y_c, ng[3], mc[5], 1.0)
            ctx = residual(ctx, swiglu(modulate(ctx, ng[4], mc[6], mc[7]), ffn_w_in[i, 1], ffn_w_out[i, 1]), ng[5], mc[8], 0.5)
    return x
```

```cpp
#include <hip/hip_runtime.h>
#include <cstdio>
#include <cstdint>
#define MK_PER_PHASE 1
namespace pg8 {
#define PG8_LAS __attribute__((address_space(3)))
typedef unsigned short bf16_t;
typedef short bf16x8 __attribute__((ext_vector_type(8)));
typedef float f32x4 __attribute__((ext_vector_type(4)));
typedef unsigned u32x4 __attribute__((ext_vector_type(4)));
constexpr int BM = 256, BK = 64, HALF = 128, HTB = HALF * BK * 2  , STAGE_BYTES = 8 * HTB, NXCD = 8, WGM = 8;

__host__ __device__ __forceinline__ int lds_byte(int r, int c) { const int st = (r >> 4) * 2 + (c >> 5), rr = r & 15, cc = c & 31, ob = rr * 64 + cc * 2; return st * 1024 + (ob ^ (((ob >> 9) & 1) << 5)); }
__host__ __device__ __forceinline__ void stage_rc(int b, int& R, int& C) { const int st = b / 1024, sb = b % 1024, swz = sb ^ (((sb >> 9) & 1) << 5); R = (st >> 1) * 16 + swz / 64; C = (st & 1) * 32 + (swz % 64) / 2; }
__host__ __device__ __forceinline__ int perm32(int rho) { const int n = rho >> 4, i = rho & 15; return 8 * (i >> 2) + 4 * n + (i & 3); }

struct Unit { int pm, pn; };
struct Gemm { const bf16_t* A; const bf16_t* Bt; int M, N, K; };

struct StaticOrder {
    int nM, nN, nwg, G, c;
    __host__ __device__ void init(int M, int N, int G_, int c_) { nM = M / BM; nN = N / BM; nwg = nM * nN; G = G_; c = c_; }
    __host__ __device__ bool next(int i, Unit& u) const {
        const long L = (long)i * G + c; if (L >= nwg) return false;
        int wgid = (int)L; { const int q = nwg / NXCD, r = nwg % NXCD, xcd = wgid % NXCD, off = wgid / NXCD; wgid = (xcd < r ? xcd * (q + 1) : r * (q + 1) + (xcd - r) * q) + off; }
        const int nig = WGM * nN, gid = wgid / nig, fm = gid * WGM, gsz = (nM - fm) < WGM ? (nM - fm) : WGM;
        u.pm = fm + ((wgid % nig) % gsz); u.pn = (wgid % nig) / gsz; return true;
    }
    __device__ __forceinline__ void a_ready(const Unit&) const {}
    __device__ __forceinline__ void done(const Unit&) const {}
};

__device__ __forceinline__ unsigned cvt_pk_bf16(float lo, float hi) { unsigned r; asm volatile("v_cvt_pk_bf16_f32 %0, %1, %2" : "=v"(r) : "v"(lo), "v"(hi)); return r; }
typedef float f32x2 __attribute__((ext_vector_type(2)));
__device__ __forceinline__ f32x2 gelu_pk(f32x2 v) {
    const f32x2 av = __builtin_elementwise_abs(v), d = av * 0.2316418882f + 1.0f;
    f32x2 t; t.x = __builtin_amdgcn_rcpf(d.x); t.y = __builtin_amdgcn_rcpf(d.y);
    f32x2 q = t * 0.5307027145f + (-0.7265760135f); q = q * t + 0.7107068705f; q = q * t + (-0.142248368f); q = q * t + 0.127414796f; q = q * t;
    const f32x2 s = (v * v) * (-0.72134752044f);
    f32x2 e; e.x = __builtin_amdgcn_exp2f(s.x); e.y = __builtin_amdgcn_exp2f(s.y);
    const f32x2 m = v * (q * e), r = v - m;
    f32x2 o; o.x = v.x < 0.f ? m.x : r.x; o.y = v.y < 0.f ? m.y : r.y; return o;
}

template <int ACT  > struct EpiBf16 {
    static constexpr bool PERM = true, AFTER_DRAIN = false; static_assert(ACT == 0 || ACT == 1, "EpiBf16: ACT is 0 (none) or 1 (gelu_pk)");
    bf16_t* O; int ldc; const float* bias; int split_cols; size_t split_stride; float scale0;
    __device__ __forceinline__ void operator()(const f32x4 (&acc)[2][2][4][2], const Unit& u, int wr, int wc, int fr, int fq) const {
        const int row0 = u.pm * BM + wr * 64 + fr; int colt = u.pn * BM; bf16_t* base = O;
        float sc = 1.f; if (split_cols) { const int t = colt / split_cols; base += (size_t)t * split_stride; colt -= t * split_cols; if (t == 0) sc = scale0; }
        const int col0 = colt + wc * 32 + 8 * fq, bcol0 = u.pn * BM + wc * 32 + 8 * fq;
        f32x4 bv[2][2];
#pragma unroll
        for (int bj = 0; bj < 2; ++bj)
#pragma unroll
            for (int n = 0; n < 2; ++n) bv[bj][n] = bias ? *(const f32x4*)(bias + bcol0 + bj * HALF + 4 * n) : (f32x4){0.f, 0.f, 0.f, 0.f};
#pragma unroll
        for (int ai = 0; ai < 2; ++ai)
#pragma unroll
            for (int m = 0; m < 4; ++m) { bf16_t* rowp = base + (size_t)(row0 + ai * HALF + m * 16) * ldc + col0;
#pragma unroll
                for (int bj = 0; bj < 2; ++bj) { f32x4 v0 = acc[ai][bj][m][0] + bv[bj][0], v1 = acc[ai][bj][m][1] + bv[bj][1];
                    if (ACT == 1) { f32x2 a = gelu_pk((f32x2){v0[0], v0[1]}), b = gelu_pk((f32x2){v0[2], v0[3]}), c = gelu_pk((f32x2){v1[0], v1[1]}), d = gelu_pk((f32x2){v1[2], v1[3]});
                        v0 = (f32x4){a.x, a.y, b.x, b.y}; v1 = (f32x4){c.x, c.y, d.x, d.y}; }
                    v0 = v0 * sc; v1 = v1 * sc; u32x4 w; w.x = cvt_pk_bf16(v0[0], v0[1]); w.y = cvt_pk_bf16(v0[2], v0[3]); w.z = cvt_pk_bf16(v1[0], v1[1]); w.w = cvt_pk_bf16(v1[2], v1[3]);
                    *(u32x4*)(rowp + bj * HALF) = w; } }
    }
};

struct PanelStats {
    unsigned* xbuf;
    unsigned* cnt;
    unsigned* tmo;
    int ntn; float eps;
    unsigned code;
    __device__ __forceinline__ bool run(const f32x4 (&v)[2][2][4][2], const Unit& u, int wr, int wc, int fr, int fq, PG8_LAS unsigned char* lds, int wid, int lane) const {
        typedef float f32x2v __attribute__((ext_vector_type(2)));
        PG8_LAS f32x2v* P = (PG8_LAS f32x2v*)lds;
        PG8_LAS f32x2v* S = (PG8_LAS f32x2v*)(lds + 8192);
        PG8_LAS unsigned* flag = (PG8_LAS unsigned*)(lds + 8192 + 2048);
#pragma unroll
        for (int ai = 0; ai < 2; ++ai)
#pragma unroll
            for (int m = 0; m < 4; ++m) {
                float s = 0.f;
#pragma unroll
                for (int bj = 0; bj < 2; ++bj)
#pragma unroll
                    for (int n = 0; n < 2; ++n) { const f32x4 x = v[ai][bj][m][n]; s += (x[0] + x[1]) + (x[2] + x[3]); }
                s += __shfl_xor(s, 16); s += __shfl_xor(s, 32);
                const float mw = s * (1.0f / 64.0f); float q = 0.f;
#pragma unroll
                for (int bj = 0; bj < 2; ++bj)
#pragma unroll
                    for (int n = 0; n < 2; ++n) { const f32x4 d = v[ai][bj][m][n] - mw; q += (d[0] * d[0] + d[1] * d[1]) + (d[2] * d[2] + d[3] * d[3]); }
                q += __shfl_xor(q, 16); q += __shfl_xor(q, 32);
                if (fq == 0) P[(ai * HALF + wr * 64 + m * 16 + fr) * 4 + wc] = (f32x2v){mw, q};
            }
        asm volatile("s_waitcnt lgkmcnt(0)" ::: "memory"); __builtin_amdgcn_s_barrier(); asm volatile("" ::: "memory");
#if defined(BROKEN_EXCHANGE_NO_WAIT)
#warning BROKEN CONTROL BUILD: the row-statistics exchange does not wait; results are wrong by design
        if (blockIdx.x >= 64) { const long long t0_ = clock64(); while (clock64() - t0_ < 60000) __builtin_amdgcn_s_sleep(8); }
#endif
        const int row = wid * 32 + (lane & 31);
        if (lane < 32) {
            const f32x2v a = P[row * 4 + 0], b = P[row * 4 + 1], c = P[row * 4 + 2], d = P[row * 4 + 3];
            const float mt = (a.x + b.x + c.x + d.x) * 0.25f;
            const float da = a.x - mt, db = b.x - mt, dc = c.x - mt, dd = d.x - mt;
            const float m2 = (a.y + b.y) + (c.y + d.y) + 64.0f * ((da * da + db * db) + (dc * dc + dd * dd));
            unsigned long long* slot = (unsigned long long*)xbuf + ((size_t)(u.pm * BM + row) * 4 + u.pn);
            __hip_atomic_store(slot, ((unsigned long long)__float_as_uint(m2) << 32) | __float_as_uint(mt), __ATOMIC_RELAXED, __HIP_MEMORY_SCOPE_AGENT);
        }
        asm volatile("s_waitcnt vmcnt(0)" ::: "memory");
        if (lane == 0) __hip_atomic_fetch_add(cnt + 64 * u.pm, 1u, __ATOMIC_RELAXED, __HIP_MEMORY_SCOPE_AGENT);
        if (wid == 0) {
            bool dead = false; const unsigned long long t0 = __builtin_amdgcn_s_memrealtime(); const unsigned want = 8u * (unsigned)ntn;
            for (;;) {
#if defined(BROKEN_EXCHANGE_NO_WAIT)
                break;
#endif
                if ((unsigned)__builtin_amdgcn_readfirstlane(__hip_atomic_load(cnt + 64 * u.pm, __ATOMIC_RELAXED, __HIP_MEMORY_SCOPE_AGENT)) >= want) break;
                if (__builtin_amdgcn_s_memrealtime() - t0 > 2000000ull) {
                    if (lane == 0) { unsigned expect = 0u; __hip_atomic_compare_exchange_strong(tmo + 1, &expect, code | (unsigned)(u.pm & 0xff), __ATOMIC_RELAXED, __ATOMIC_RELAXED, __HIP_MEMORY_SCOPE_AGENT);
                                     __hip_atomic_store(tmo, 1u, __ATOMIC_RELAXED, __HIP_MEMORY_SCOPE_AGENT); }
                    dead = true; break; }
                __builtin_amdgcn_s_sleep(2);
            }
            __builtin_amdgcn_fence(__ATOMIC_ACQUIRE, "agent");
            if (lane == 0) flag[0] = dead ? 1u : 0u;
        }
        asm volatile("s_waitcnt vmcnt(0) lgkmcnt(0)" ::: "memory"); __builtin_amdgcn_s_barrier(); asm volatile("" ::: "memory");
        const bool bad = flag[0] != 0u;
        if (lane < 32) {
            const unsigned long long* slot = (const unsigned long long*)xbuf + (size_t)(u.pm * BM + row) * 4; float mt[4], m2[4]; float ms = 0.f;
#pragma unroll
            for (int t = 0; t < 4; ++t) { if (t < ntn) { const unsigned long long w = __hip_atomic_load(slot + t, __ATOMIC_RELAXED, __HIP_MEMORY_SCOPE_AGENT); mt[t] = __uint_as_float((unsigned)w); m2[t] = __uint_as_float((unsigned)(w >> 32)); } else { mt[t] = 0.f; m2[t] = 0.f; } ms += mt[t]; }
            const float mean = ms / (float)ntn; float q = 0.f;
#pragma unroll
            for (int t = 0; t < 4; ++t) if (t < ntn) { const float dm = mt[t] - mean; q += m2[t] + 256.0f * dm * dm; }
            S[row] = (f32x2v){mean, 1.0f / sqrtf(q / (256.0f * (float)ntn) + eps)};
        }
        asm volatile("s_waitcnt lgkmcnt(0)" ::: "memory"); __builtin_amdgcn_s_barrier(); asm volatile("" ::: "memory");
        return bad;
    }
};
struct EpiLnRes {
    static constexpr bool PERM = false, AFTER_DRAIN = true;
    const float* base; float* out; int ldc; const float* bias; PanelStats st; unsigned poison;
    __device__ __forceinline__ void fused(f32x4 (&acc)[2][2][4][2], const Unit& u, int wr, int wc, int fr, int fq, PG8_LAS unsigned char* lds, int wid, int lane) const {
        typedef float f32x2v __attribute__((ext_vector_type(2)));
        const PG8_LAS f32x2v* S = (const PG8_LAS f32x2v*)(lds + 8192);
        const int col0 = u.pn * BM + wc * 32 + 4 * fq;
#pragma unroll
        for (int bj = 0; bj < 2; ++bj)
#pragma unroll
            for (int n = 0; n < 2; ++n) { const f32x4 bv = bias ? *(const f32x4*)(bias + col0 + bj * HALF + n * 16) : (f32x4){0.f, 0.f, 0.f, 0.f};
#pragma unroll
                for (int ai = 0; ai < 2; ++ai)
#pragma unroll
                    for (int m = 0; m < 4; ++m) acc[ai][bj][m][n] += bv; }
        f32x4 pre[4][2][2];
#pragma unroll
        for (int m = 0; m < 4; ++m) { const size_t off = (size_t)(u.pm * BM + wr * 64 + m * 16 + fr) * ldc + col0;
#pragma unroll
            for (int bj = 0; bj < 2; ++bj)
#pragma unroll
                for (int n = 0; n < 2; ++n) pre[m][bj][n] = *(const f32x4*)(base + off + bj * HALF + n * 16); }
        const bool bad = st.run(acc, u, wr, wc, fr, fq, lds, wid, lane) || poison != 0u;
        const float qnan = __builtin_nanf("");
#pragma unroll
        for (int ai = 0; ai < 2; ++ai)
#pragma unroll
            for (int m = 0; m < 4; ++m) { const int r = ai * HALF + wr * 64 + m * 16 + fr; const f32x2v sr = S[r]; const size_t off = (size_t)(u.pm * BM + r) * ldc + col0;
#pragma unroll
                for (int bj = 0; bj < 2; ++bj)
#pragma unroll
                    for (int n = 0; n < 2; ++n) { const f32x4 bs = ai == 0 ? pre[m][bj][n] : *(const f32x4*)(base + off + bj * HALF + n * 16); f32x4 o = bs + (acc[ai][bj][m][n] - sr.x) * sr.y;
                        if (bad) o = (f32x4){qnan, qnan, qnan, qnan}; *(f32x4*)(out + off + bj * HALF + n * 16) = o; }
                if (m & 1) asm volatile("" ::: "memory"); }
    }
};
struct EpiLnResLn {
    static constexpr bool PERM = false, AFTER_DRAIN = true;
    const float* base; float* out; bf16_t* xn; int ldc; const float* bias; PanelStats st1, st2; unsigned poison;
    __device__ __forceinline__ void fused(f32x4 (&acc)[2][2][4][2], const Unit& u, int wr, int wc, int fr, int fq, PG8_LAS unsigned char* lds, int wid, int lane) const {
        typedef float f32x2v __attribute__((ext_vector_type(2))); typedef unsigned u32x2v __attribute__((ext_vector_type(2)));
        const PG8_LAS f32x2v* S = (const PG8_LAS f32x2v*)(lds + 8192);
        const int col0 = u.pn * BM + wc * 32 + 4 * fq;
#pragma unroll
        for (int bj = 0; bj < 2; ++bj)
#pragma unroll
            for (int n = 0; n < 2; ++n) { const f32x4 bv = bias ? *(const f32x4*)(bias + col0 + bj * HALF + n * 16) : (f32x4){0.f, 0.f, 0.f, 0.f};
#pragma unroll
                for (int ai = 0; ai < 2; ++ai)
#pragma unroll
                    for (int m = 0; m < 4; ++m) acc[ai][bj][m][n] += bv; }
        bool bad = st1.run(acc, u, wr, wc, fr, fq, lds, wid, lane) || poison != 0u;
        const float qnan = __builtin_nanf("");
#pragma unroll
        for (int ai = 0; ai < 2; ++ai)
#pragma unroll
            for (int m = 0; m < 4; ++m) { const int r = ai * HALF + wr * 64 + m * 16 + fr; const f32x2v sr = S[r]; const size_t off = (size_t)(u.pm * BM + r) * ldc + col0;
#pragma unroll
                for (int bj = 0; bj < 2; ++bj)
#pragma unroll
                    for (int n = 0; n < 2; ++n) { const f32x4 bs = *(const f32x4*)(base + off + bj * HALF + n * 16); acc[ai][bj][m][n] = bs + (acc[ai][bj][m][n] - sr.x) * sr.y; }
                asm volatile("" : "+v"(acc[ai][0][m][0]), "+v"(acc[ai][0][m][1]), "+v"(acc[ai][1][m][0]), "+v"(acc[ai][1][m][1]));
                if (m & 1) asm volatile("" ::: "memory"); }
        const bool bad1 = bad;
        bad = st2.run(acc, u, wr, wc, fr, fq, lds, wid, lane) || bad;
#pragma unroll
        for (int ai = 0; ai < 2; ++ai)
#pragma unroll
            for (int m = 0; m < 4; ++m) { const int r = ai * HALF + wr * 64 + m * 16 + fr; const f32x2v sr = S[r]; const size_t off = (size_t)(u.pm * BM + r) * ldc + col0;
#pragma unroll
                for (int bj = 0; bj < 2; ++bj)
#pragma unroll
                    for (int n = 0; n < 2; ++n) { const f32x4 x1 = acc[ai][bj][m][n]; *(f32x4*)(out + off + bj * HALF + n * 16) = bad1 ? (f32x4){qnan, qnan, qnan, qnan} : x1;
                        const f32x4 o = (x1 - sr.x) * sr.y; u32x2v w; w.x = cvt_pk_bf16(o[0], o[1]); w.y = cvt_pk_bf16(o[2], o[3]);
                        if (bad) { w.x = 0x7fc07fc0u; w.y = 0x7fc07fc0u; } *(u32x2v*)(xn + off + bj * HALF + n * 16) = w; }
                asm volatile("" ::: "memory"); }
    }
};

template <class Epi, class Sched, bool ALIGN_EPI = false, bool SP2 = false>
__device__ __forceinline__ void gemm_phase(PG8_LAS unsigned char* lds, const Gemm g, const Sched& S, const Epi& E) {
    int tid_ = threadIdx.x; asm volatile("" : "+v"(tid_));
    const int tid = tid_, wid = __builtin_amdgcn_readfirstlane(tid >> 6), lane = tid & 63, wr = wid >> 2, wc = wid & 3, fr = lane & 15, fq = lane >> 4;
    const int K = g.K, nt = K / BK;
    unsigned voffA[2], voffB[2];
#pragma unroll
    for (int i = 0; i < 2; ++i) { int R, C; stage_rc(tid * 16 + i * 8192, R, C); const int Rb = Epi::PERM ? ((R & ~31) + perm32(R & 31)) : R;
        voffA[i] = (unsigned)(R * K + C) * 2u; voffB[i] = (unsigned)(Rb * K + C) * 2u; }
    const size_t kstep = (size_t)(BK * 2);
    const size_t hstep = (size_t)HALF * K * 2;
    const size_t tstep = 2 * hstep;
    const unsigned ldsw = (unsigned)wid * 1024u;
    const int aoff = lds_byte(wr * 64 + fr, fq * 8), boff = lds_byte(wc * 32 + fr, fq * 8);
#define PG8_SA(b, h) (((b) * 2 + (h)) * HTB)
#define PG8_SB(b, h) ((4 + (b) * 2 + (h)) * HTB)
#define PG8_STAGE(bufoff, gbase, voff) do { _Pragma("unroll") for (int _i = 0; _i < 2; ++_i) \
        __builtin_amdgcn_global_load_lds((const unsigned*)((const char*)(gbase) + (voff)[_i]), (PG8_LAS unsigned*)(lds + (bufoff) + ldsw + _i * 8192), 16, 0, 0); } while (0)
#define PG8_LDA(dst, b, h) do { _Pragma("unroll") for (int m = 0; m < 4; ++m) _Pragma("unroll") for (int k = 0; k < 2; ++k) dst[m][k] = *(const PG8_LAS bf16x8*)(lds + PG8_SA(b, h) + aoff + m * 2048 + k * 1024); } while (0)
#define PG8_LDB(dst, b, h) do { _Pragma("unroll") for (int n = 0; n < 2; ++n) _Pragma("unroll") for (int k = 0; k < 2; ++k) dst[n][k] = *(const PG8_LAS bf16x8*)(lds + PG8_SB(b, h) + boff + n * 2048 + k * 1024); } while (0)
#define PG8_MMA(ai, bj, At, Bt) do { __builtin_amdgcn_s_setprio(1); _Pragma("unroll") for (int m = 0; m < 4; ++m) _Pragma("unroll") for (int n = 0; n < 2; ++n) _Pragma("unroll") for (int k = 0; k < 2; ++k) \
        acc[ai][bj][m][n] = __builtin_amdgcn_mfma_f32_16x16x32_bf16(Bt[n][k], At[m][k], acc[ai][bj][m][n], 0, 0, 0); __builtin_amdgcn_s_setprio(0); } while (0)
#define PG8_WAIT_V(n) asm volatile("s_waitcnt vmcnt(" #n ")" ::: "memory")
#define PG8_WAIT_L(n) asm volatile("s_waitcnt lgkmcnt(" #n ")" ::: "memory")
#define PG8_BAR __builtin_amdgcn_s_barrier()
#define PG8_SCHED __builtin_amdgcn_sched_barrier(0)
    Unit cur, nxt; int ui = 0;
    if (!S.next(0, cur)) return;
    f32x4 acc[2][2][4][2];
#pragma unroll
    for (int a = 0; a < 2; ++a)
#pragma unroll
        for (int b = 0; b < 2; ++b)
#pragma unroll
            for (int m = 0; m < 4; ++m)
#pragma unroll
                for (int n = 0; n < 2; ++n) acc[a][b][m][n] = (f32x4){0.f, 0.f, 0.f, 0.f};
    bf16x8 At[4][2], B0[2][2], B1[2][2];
    const char* cA = (const char*)g.A + (size_t)cur.pm * tstep; const char* cB = (const char*)g.Bt + (size_t)cur.pn * tstep;
    S.a_ready(cur);
    if constexpr (SP2) {
        PG8_STAGE(PG8_SB(0, 0), cB, voffB); PG8_STAGE(PG8_SB(0, 1), cB + hstep, voffB); PG8_STAGE(PG8_SA(0, 0), cA, voffA); PG8_STAGE(PG8_SA(0, 1), cA + hstep, voffA);
        if (wr == 1) PG8_BAR;
        PG8_WAIT_V(2); PG8_BAR;
        PG8_STAGE(PG8_SB(1, 0), cB + kstep, voffB); PG8_STAGE(PG8_SA(1, 0), cA + kstep, voffA); PG8_STAGE(PG8_SB(1, 1), cB + hstep + kstep, voffB);
        PG8_WAIT_V(6); PG8_BAR;
    } else {
        PG8_STAGE(PG8_SB(0, 0), cB, voffB); PG8_STAGE(PG8_SA(0, 0), cA, voffA); PG8_STAGE(PG8_SB(0, 1), cB + hstep, voffB); PG8_STAGE(PG8_SA(0, 1), cA + hstep, voffA);
        if (wr == 1) PG8_BAR;
        PG8_WAIT_V(4); PG8_BAR;
        PG8_STAGE(PG8_SB(1, 0), cB + kstep, voffB); PG8_STAGE(PG8_SA(1, 0), cA + kstep, voffA); PG8_STAGE(PG8_SB(1, 1), cB + hstep + kstep, voffB);
        PG8_WAIT_V(6); PG8_BAR;
    }
    for (;;) {
        const bool has_next = S.next(ui + 1, nxt);
        const char* nA = has_next ? (const char*)g.A + (size_t)nxt.pm * tstep : cA; const char* nB = has_next ? (const char*)g.Bt + (size_t)nxt.pn * tstep : cB;
        for (int t = 0; t < nt; t += 2) {
            const bool last = (t == nt - 2);
            const char* a1 = cA + (size_t)(t + 1) * kstep;
            const char* a2 = last ? nA : cA + (size_t)(t + 2) * kstep; const char* b2 = last ? nB : cB + (size_t)(t + 2) * kstep;
            const char* a3 = a2 + kstep; const char* b3 = b2 + kstep;
            if (last && has_next) S.a_ready(nxt);
            if constexpr (SP2) {
            PG8_LDB(B0, 0, 0); PG8_LDB(B1, 0, 1); PG8_SCHED; PG8_LDA(At, 0, 0); PG8_STAGE(PG8_SA(1, 1), a1 + hstep, voffA);
            PG8_WAIT_V(8); PG8_WAIT_L(0); PG8_BAR; PG8_MMA(0, 0, At, B0); PG8_MMA(0, 1, At, B1); PG8_BAR; PG8_SCHED;
            PG8_LDA(At, 0, 1); PG8_STAGE(PG8_SB(0, 0), b2, voffB); PG8_STAGE(PG8_SB(0, 1), b2 + hstep, voffB); PG8_STAGE(PG8_SA(0, 0), a2, voffA);
            PG8_WAIT_V(8); PG8_WAIT_L(0); PG8_BAR; PG8_MMA(1, 0, At, B0); PG8_MMA(1, 1, At, B1); PG8_BAR; PG8_SCHED;
            PG8_LDB(B0, 1, 0); PG8_LDB(B1, 1, 1); PG8_SCHED; PG8_LDA(At, 1, 0); PG8_STAGE(PG8_SA(0, 1), a2 + hstep, voffA);
            PG8_WAIT_V(8); PG8_WAIT_L(0); PG8_BAR; PG8_MMA(0, 0, At, B0); PG8_MMA(0, 1, At, B1); PG8_BAR; PG8_SCHED;
            PG8_LDA(At, 1, 1); PG8_STAGE(PG8_SB(1, 0), b3, voffB); PG8_STAGE(PG8_SB(1, 1), b3 + hstep, voffB); PG8_STAGE(PG8_SA(1, 0), a3, voffA);
            PG8_WAIT_V(8); PG8_WAIT_L(0); PG8_BAR; PG8_MMA(1, 0, At, B0); PG8_MMA(1, 1, At, B1); PG8_BAR; PG8_SCHED;
            } else {
            PG8_LDB(B0, 0, 0); PG8_SCHED; PG8_LDA(At, 0, 0); PG8_STAGE(PG8_SA(1, 1), a1 + hstep, voffA);
            PG8_WAIT_L(8); PG8_BAR; PG8_WAIT_L(0); PG8_MMA(0, 0, At, B0); PG8_BAR; PG8_SCHED;
            PG8_LDB(B1, 0, 1); PG8_STAGE(PG8_SB(0, 0), b2, voffB);
            PG8_BAR; PG8_WAIT_L(0); PG8_MMA(0, 1, At, B1); PG8_BAR;
            PG8_LDA(At, 0, 1); PG8_STAGE(PG8_SA(0, 0), a2, voffA);
            PG8_BAR; PG8_WAIT_L(0); PG8_MMA(1, 0, At, B0); PG8_BAR; PG8_SCHED;
            PG8_STAGE(PG8_SB(0, 1), b2 + hstep, voffB);
            PG8_WAIT_V(6); PG8_BAR; PG8_MMA(1, 1, At, B1); PG8_BAR;
            PG8_LDB(B0, 1, 0); PG8_SCHED; PG8_LDA(At, 1, 0); PG8_STAGE(PG8_SA(0, 1), a2 + hstep, voffA);
            PG8_WAIT_L(8); PG8_BAR; PG8_WAIT_L(0); PG8_MMA(0, 0, At, B0); PG8_BAR; PG8_SCHED;
            PG8_LDB(B1, 1, 1); PG8_STAGE(PG8_SB(1, 0), b3, voffB);
            PG8_BAR; PG8_WAIT_L(0); PG8_MMA(0, 1, At, B1); PG8_BAR;
            PG8_LDA(At, 1, 1); PG8_STAGE(PG8_SA(1, 0), a3, voffA);
            PG8_BAR; PG8_WAIT_L(0); PG8_MMA(1, 0, At, B0); PG8_BAR; PG8_SCHED;
            PG8_STAGE(PG8_SB(1, 1), b3 + hstep, voffB);
            PG8_WAIT_V(6); PG8_BAR; PG8_MMA(1, 1, At, B1); PG8_BAR;
            }
        }
        if constexpr (ALIGN_EPI) { if (wr == 0) PG8_BAR; }
        if constexpr (!Epi::AFTER_DRAIN) { E(acc, cur, wr, wc, fr, fq); S.done(cur); }
        if (!has_next) break;
#pragma unroll
        for (int a = 0; a < 2; ++a)
#pragma unroll
            for (int b = 0; b < 2; ++b)
#pragma unroll
                for (int m = 0; m < 4; ++m)
#pragma unroll
                    for (int n = 0; n < 2; ++n) acc[a][b][m][n] = (f32x4){0.f, 0.f, 0.f, 0.f};
        cur = nxt; cA = nA; cB = nB; ++ui;
        if constexpr (ALIGN_EPI) { if (wr == 1) PG8_BAR; }
    }
    PG8_WAIT_V(0);
    if constexpr (!ALIGN_EPI) { if (wr == 0) PG8_BAR; }
    PG8_BAR;
    if constexpr (Epi::AFTER_DRAIN) { E.fused(acc, cur, wr, wc, fr, fq, lds, wid, lane); S.done(cur); }
#undef PG8_SA
#undef PG8_SB
#undef PG8_STAGE
#undef PG8_LDA
#undef PG8_LDB
#undef PG8_MMA
#undef PG8_WAIT_V
#undef PG8_WAIT_L
#undef PG8_BAR
#undef PG8_SCHED
}
}

#ifndef PG8_SP2
#define PG8_SP2 true
#endif
#ifndef PG8_ALIGN
#define PG8_ALIGN true
#endif

#define GAS __attribute__((address_space(1)))
#define LAS __attribute__((address_space(3)))

namespace mk {
using pg8::bf16_t; using pg8::bf16x8; using pg8::f32x4; using pg8::u32x4; using pg8::Unit;
typedef float f32x2 __attribute__((ext_vector_type(2)));
typedef unsigned u32x2 __attribute__((ext_vector_type(2)));
typedef __bf16 bf16x2_t __attribute__((ext_vector_type(2)));

constexpr int NWAVES = 8, NTHREADS = 512;
constexpr int D = 1024, BATCH = 2, SEQ = 8192, CTXL = 256, DEPTH = 4, DFF = 2816, DI = 2048, NH = 4, DH = 512, EH = 3072;
constexpr int ML = BATCH * SEQ, MC = BATCH * CTXL, R = ML + MC;
constexpr int NPOS = CTXL + SEQ, NCHUNK = NPOS / 64;
constexpr float EPS = 1e-6f;

constexpr size_t MiB = 1u << 20;
constexpr size_t WS_CTL = 0, CTL_ZERO_BYTES = 1 * MiB;
constexpr size_t WS_MOD = 1 * MiB;
constexpr size_t WS_CTXS = 2 * MiB;
constexpr size_t WS_GATES = 4 * MiB;
constexpr size_t WS_WCM = 5 * MiB + 256 * 1024;
constexpr size_t WS_GB = 6 * MiB, WS_GM = WS_GB + 640 * 1024, WS_GI = WS_GM + 640 * 1024;
constexpr size_t WS_WFI = 8 * MiB, WS_WFO = 96 * MiB, WS_WAI = 140 * MiB, WS_WAO = 156 * MiB, WS_WBI = 164 * MiB, WS_WBO = 188 * MiB;
constexpr size_t WS_XN = 200 * MiB, WS_Y = 233 * MiB, WS_NUMB = 200 * MiB;
constexpr size_t WS_T0 = 266 * MiB;
constexpr size_t WS_H = WS_T0;
constexpr size_t WS_U = WS_T0, WS_V = 365 * MiB, WS_VST = 464 * MiB;
constexpr size_t WS_XM = WS_T0, WS_NUMF = WS_T0, WS_Z = 332 * MiB, WS_XC = 398 * MiB, WS_Q = 464 * MiB, WS_G = WS_Q, WS_K = 530 * MiB, WS_VV = 596 * MiB;
constexpr size_t WS_SRAW = 662 * MiB, WS_PD = 671 * MiB, WS_END = 680 * MiB;
constexpr int CW_BAR = 4096;

constexpr int RING_BYTES = 131072, LDSCTL_OFF = RING_BYTES, MISC_OFF = LDSCTL_OFF + 320, LDS_BYTES = 147456;

__device__ __forceinline__ unsigned cvtpk(float lo, float hi) { f32x2 v = {lo, hi}; bf16x2_t b = __builtin_convertvector(v, bf16x2_t); return __builtin_bit_cast(unsigned, b); }
__device__ __forceinline__ float bflo(unsigned u) { return __builtin_bit_cast(float, u << 16); }
__device__ __forceinline__ float bfhi(unsigned u) { return __builtin_bit_cast(float, u & 0xffff0000u); }
__device__ __forceinline__ float bf2f(bf16_t u) { return __builtin_bit_cast(float, (unsigned)u << 16); }
__device__ __forceinline__ bf16_t f2bf(float f) { return (bf16_t)(cvtpk(f, 0.f) & 0xffffu); }
__device__ __forceinline__ float wave_sum(float v) {
#pragma unroll
    for (int o = 1; o < 64; o <<= 1) v += __shfl_xor(v, o);
    return v;
}
__device__ __forceinline__ float silu_f(float v) { return v * __builtin_amdgcn_rcpf(1.0f + __expf(-v)); }
__device__ __forceinline__ f32x4 mfma16(bf16x8 a, bf16x8 b, f32x4 c) { return __builtin_amdgcn_mfma_f32_16x16x32_bf16(a, b, c, 0, 0, 0); }
#define LDS_WAIT() asm volatile("s_waitcnt lgkmcnt(0)" ::: "memory")
#define VM_WAIT() asm volatile("s_waitcnt vmcnt(0)" ::: "memory")

#define XB_TMO      128
#define XB_XCNT(j)  (256  + 64 * (j))
#define XB_XSUB(j)  (1280 + 64 * (j))
#define XB_XGEN(j)  (2304 + 64 * (j))
#define XB_TOP      3328
#define XB_TOPGEN   3392
#define XCD_BAR_WORDS 3456
#define XB_SPIN_CAP (1u << 18)
__device__ __forceinline__ unsigned xb_ld(unsigned* p)              { return __hip_atomic_load(p, __ATOMIC_RELAXED, __HIP_MEMORY_SCOPE_AGENT); }
__device__ __forceinline__ unsigned xb_add(unsigned* p, unsigned v) { return __hip_atomic_fetch_add(p, v, __ATOMIC_RELAXED, __HIP_MEMORY_SCOPE_AGENT); }
__device__ __forceinline__ unsigned xb_xcc_id() { return (unsigned)__builtin_amdgcn_s_getreg((3 << 11) | 20) & 0xFu; }
#define XB_SPIN(cond, bar) do { unsigned _sp = 0; while (cond) { __builtin_amdgcn_s_sleep(1); \
    if ((++_sp & 255u) == 0u) { if (xb_ld(&(bar)[XB_TMO])) break; if (_sp > XB_SPIN_CAP) { atomicAdd(&(bar)[XB_TMO], 1u); break; } } } } while (0)
struct XcdBarrier { unsigned* bar; unsigned x; volatile LAS unsigned* st; };
__device__ __forceinline__ XcdBarrier xcd_barrier_post(unsigned* bar, volatile LAS unsigned* st) {
    XcdBarrier b; b.bar = bar; b.x = xb_xcc_id(); b.st = st;
    if (threadIdx.x == 0) (void)xb_add(&bar[XB_XCNT(b.x)], 1u);
    return b;
}
__device__ __forceinline__ void xcd_barrier_complete(unsigned* bar, unsigned x, unsigned& nloc, unsigned& nx) {
    const unsigned G = gridDim.x * gridDim.y * gridDim.z;
    unsigned sum, cnt, mine, sp = 0u;
    for (;;) {
        sum = 0u; cnt = 0u; mine = 0u;
#pragma unroll
        for (unsigned j = 0; j < 16; ++j) { const unsigned c = xb_ld(&bar[XB_XCNT(j)]); sum += c; cnt += (c > 0u) ? 1u : 0u; mine = (j == x) ? c : mine; }
        if (sum == G) break;
        __builtin_amdgcn_s_sleep(1);
        if ((++sp & 255u) == 0u) { if (xb_ld(&bar[XB_TMO])) break; if (sp > XB_SPIN_CAP) { atomicAdd(&bar[XB_TMO], 1u); break; } }
    }
    nloc = mine > 0u ? mine : 1u; nx = cnt > 0u ? cnt : 1u;
}
__device__ __forceinline__ void xcd_barrier(const XcdBarrier& b) {
    asm volatile("s_waitcnt vmcnt(0)" ::: "memory");
    __syncthreads();
    if (threadIdx.x == 0) {
        unsigned* bar = b.bar;
        __builtin_amdgcn_s_waitcnt(0);
        unsigned nloc = b.st[0], nx = b.st[1];
        if (nloc == 0u) { xcd_barrier_complete(bar, b.x, nloc, nx); b.st[0] = nloc; b.st[1] = nx; }
        const unsigned old = xb_add(&bar[XB_XSUB(b.x)], 1u);
        const unsigned gen = old / nloc;
        if (old + 1u == (gen + 1u) * nloc) {
            __builtin_amdgcn_fence(__ATOMIC_RELEASE, "agent");
            asm volatile("s_waitcnt vmcnt(0)" ::: "memory");
            const unsigned og = xb_add(&bar[XB_TOP], 1u);
            const unsigned tg = og / nx;
            if (og + 1u == (tg + 1u) * nx) xb_add(&bar[XB_TOPGEN], 1u);
            else XB_SPIN(xb_ld(&bar[XB_TOPGEN]) == tg, bar);
            __builtin_amdgcn_fence(__ATOMIC_ACQUIRE, "agent");
            xb_add(&bar[XB_XGEN(b.x)], 1u);
            asm volatile("s_waitcnt vmcnt(0)" ::: "memory");
        } else {
            XB_SPIN(xb_ld(&bar[XB_XGEN(b.x)]) == gen, bar);
            __builtin_amdgcn_fence(__ATOMIC_ACQUIRE, "agent");
            asm volatile("s_waitcnt vmcnt(0)" ::: "memory");
        }
    }
    __syncthreads();
}

struct EpiSwiGLU {
    static constexpr bool PERM = true, AFTER_DRAIN = false;
    bf16_t* O; int ldc;
    __device__ __forceinline__ void operator()(const f32x4 (&acc)[2][2][4][2], const Unit& u, int wr, int wc, int fr, int fq) const {
        const int row0 = u.pm * 256 + wr * 64 + fr, col0 = u.pn * 128 + wc * 32 + 8 * fq;
#pragma unroll
        for (int ai = 0; ai < 2; ++ai)
#pragma unroll
            for (int m = 0; m < 4; ++m) {
                bf16_t* rowp = O + (size_t)(row0 + ai * 128 + m * 16) * ldc + col0;
                const f32x4 g0 = acc[ai][0][m][0], g1 = acc[ai][0][m][1], u0 = acc[ai][1][m][0], u1 = acc[ai][1][m][1];
                u32x4 w;
                w.x = cvtpk(silu_f(g0[0]) * u0[0], silu_f(g0[1]) * u0[1]); w.y = cvtpk(silu_f(g0[2]) * u0[2], silu_f(g0[3]) * u0[3]);
                w.z = cvtpk(silu_f(g1[0]) * u1[0], silu_f(g1[1]) * u1[1]); w.w = cvtpk(silu_f(g1[2]) * u1[2], silu_f(g1[3]) * u1[3]);
                *(u32x4*)rowp = w;
            }
    }
};
struct EpiGeluUV {
    static constexpr bool PERM = true, AFTER_DRAIN = false;
    bf16_t* U; bf16_t* V; const float* bias; float* vst;
    __device__ __forceinline__ void operator()(const f32x4 (&acc)[2][2][4][2], const Unit& u, int wr, int wc, int fr, int fq) const {
        const int row0 = u.pm * 256 + wr * 64 + fr;
        const int t = (u.pn >= 12) ? 1 : 0;
        bf16_t* base = t ? V : U;
        const int col0 = (u.pn - 12 * t) * 256 + wc * 32 + 8 * fq, bcol0 = u.pn * 256 + wc * 32 + 8 * fq;
        f32x4 bv[2][2];
#pragma unroll
        for (int bj = 0; bj < 2; ++bj)
#pragma unroll
            for (int n = 0; n < 2; ++n) bv[bj][n] = *(const f32x4*)(bias + bcol0 + bj * 128 + 4 * n);
#pragma unroll
        for (int ai = 0; ai < 2; ++ai)
#pragma unroll
            for (int m = 0; m < 4; ++m) {
                const int row = row0 + ai * 128 + m * 16;
                bf16_t* rowp = base + (size_t)row * EH + col0;
                float s = 0.f, q = 0.f;
#pragma unroll
                for (int bj = 0; bj < 2; ++bj) {
                    f32x4 v0 = acc[ai][bj][m][0] + bv[bj][0], v1 = acc[ai][bj][m][1] + bv[bj][1];
                    pg8::f32x2 a = pg8::gelu_pk((pg8::f32x2){v0[0], v0[1]}), b = pg8::gelu_pk((pg8::f32x2){v0[2], v0[3]}), c = pg8::gelu_pk((pg8::f32x2){v1[0], v1[1]}), d = pg8::gelu_pk((pg8::f32x2){v1[2], v1[3]});
                    u32x4 w; w.x = cvtpk(a.x, a.y); w.y = cvtpk(b.x, b.y); w.z = cvtpk(c.x, c.y); w.w = cvtpk(d.x, d.y);
                    *(u32x4*)(rowp + bj * 128) = w;
                    s += (a.x + a.y) + (b.x + b.y) + (c.x + c.y) + (d.x + d.y);
                    q += (a.x * a.x + a.y * a.y) + (b.x * b.x + b.y * b.y) + (c.x * c.x + c.y * c.y) + (d.x * d.x + d.y * d.y);
                }
                if (t) {
                    s += __shfl_xor(s, 16); s += __shfl_xor(s, 32); q += __shfl_xor(q, 16); q += __shfl_xor(q, 32);
                    if (fq == 0) *(f32x2*)(vst + ((size_t)row * 48 + (u.pn - 12) * 4 + wc) * 2) = (f32x2){s, q};
                }
            }
    }
};

__device__ __forceinline__ void p0_transpose_item(const float* W, int K, int N, bf16_t* WT, int mode, LAS float* scr, int item, int lane) {
    const int nblk = N / 32, kb = item / nblk, nb = item % nblk, k0 = 64 * kb, n0 = 32 * nb;
    int orow0 = n0;
    if (mode) { const int hh = (n0 < DFF) ? n0 : n0 - DFF; orow0 = (hh >> 7) * 256 + (hh & 127) + ((n0 < DFF) ? 0 : 128); }
#pragma unroll 8
    for (int i = 0; i < 32; ++i) { const int kk = 2 * i + (lane >> 5); scr[kk * 33 + (lane & 31)] = W[(size_t)(k0 + kk) * N + n0 + (lane & 31)]; }
    LDS_WAIT(); asm volatile("" ::: "memory");
    const int c = lane & 7;
#pragma unroll
    for (int j = 0; j < 4; ++j) { const int n = (lane >> 3) + 8 * j; const LAS float* s = scr + (8 * c) * 33 + n;
        u32x4 o; o.x = cvtpk(s[0 * 33], s[1 * 33]); o.y = cvtpk(s[2 * 33], s[3 * 33]); o.z = cvtpk(s[4 * 33], s[5 * 33]); o.w = cvtpk(s[6 * 33], s[7 * 33]);
        *(u32x4*)(WT + (size_t)(orow0 + n) * K + k0 + 8 * c) = o; }
    LDS_WAIT(); asm volatile("" ::: "memory");
}
__device__ __forceinline__ void adaln_unit(const float* c, const float* cctx, const float* w_ada, const float* b_ada, float* MOD, LAS unsigned char* lds, int unit, int tid, int wave, int lane) {
    asm volatile("" : "+v"(tid), "+v"(lane));
    LAS float* sc = (LAS float*)lds;
    LAS float* red = sc + 3 * 1024;
    const int layer = unit / 36, cb = unit % 36;
    for (int i = tid; i < 3072; i += NTHREADS) { const int b = i >> 10, k = i & 1023; const float v = (b < 2) ? c[b * 1024 + k] : cctx[k]; sc[i] = v / (1.0f + __expf(-v)); }
    __syncthreads();
    const float* wp = w_ada + ((size_t)layer * 1024 + wave * 128) * 9216 + cb * 256 + lane * 4;
    f32x4 a0 = {0.f, 0.f, 0.f, 0.f}, a1 = a0, a2 = a0;
#pragma unroll 8
    for (int kk = 0; kk < 128; ++kk) { const f32x4 w = *(const f32x4*)(wp + (size_t)kk * 9216); const int k = wave * 128 + kk;
        a0 += w * sc[k]; a1 += w * sc[1024 + k]; a2 += w * sc[2048 + k]; }
    *(LAS f32x4*)(red + (wave * 3 + 0) * 256 + lane * 4) = a0; *(LAS f32x4*)(red + (wave * 3 + 1) * 256 + lane * 4) = a1; *(LAS f32x4*)(red + (wave * 3 + 2) * 256 + lane * 4) = a2;
    __syncthreads();
    for (int o = tid; o < 768; o += NTHREADS) { const int b = o >> 8, col = o & 255; float s = b_ada[layer * 9216 + cb * 256 + col];
#pragma unroll
        for (int w = 0; w < 8; ++w) s += red[(w * 3 + b) * 256 + col];
        MOD[(size_t)(layer * 3 + b) * 9216 + cb * 256 + col] = s; }
    __syncthreads();
}

struct ThinP { int first, has_y, lp, gate_i, gpost_i; float wgt; int has_next, ln, gpre_i, shift_i, scale_i; };
__device__ __forceinline__ void thin_phase(const ThinP p, const float* xin, const float* ctxin, float* X, float* CTXS, const bf16_t* Y, bf16_t* XN, const float* MOD, const float* normg, int gw, int NGW, int lane) {
    asm volatile("" : "+v"(lane));
    for (int r = gw; r < R; r += NGW) {
        const int bsel = (r < ML) ? (r >> 13) : 2;
        float* xr = (r < ML) ? X + (size_t)r * D : CTXS + (size_t)(r - ML) * D;
        const float* src = p.first ? ((r < ML) ? xin + (size_t)r * D : ctxin + (size_t)(r - ML) * D) : xr;
        f32x4 x[4];
#pragma unroll
        for (int j = 0; j < 4; ++j) x[j] = *(const f32x4*)(src + 4 * lane + 256 * j);
        if (p.has_y) {
            f32x4 y[4]; float ss = 0.f;
#pragma unroll
            for (int j = 0; j < 4; ++j) { const u32x2 w = *(const u32x2*)(Y + (size_t)r * D + 4 * lane + 256 * j); y[j] = (f32x4){bflo(w.x), bfhi(w.x), bflo(w.y), bfhi(w.y)};
                ss += (y[j].x * y[j].x + y[j].y * y[j].y) + (y[j].z * y[j].z + y[j].w * y[j].w); }
            const float rinv = 1.0f / sqrtf(wave_sum(ss) * (1.0f / D) + EPS) * p.wgt;
            const float* gate = MOD + (size_t)(p.lp * 3 + bsel) * 9216 + p.gate_i * D; const float* gp = normg + (size_t)(p.lp * 6 + p.gpost_i) * D;
#pragma unroll
            for (int j = 0; j < 4; ++j) { const f32x4 g = *(const f32x4*)(gate + 4 * lane + 256 * j), q = *(const f32x4*)(gp + 4 * lane + 256 * j); x[j] += g * q * y[j] * rinv; }
        }
        if (p.first || p.has_y) {
#pragma unroll
            for (int j = 0; j < 4; ++j) *(f32x4*)(xr + 4 * lane + 256 * j) = x[j];
        }
        if (p.has_next) {
            float ss = 0.f;
#pragma unroll
            for (int j = 0; j < 4; ++j) ss += (x[j].x * x[j].x + x[j].y * x[j].y) + (x[j].z * x[j].z + x[j].w * x[j].w);
            const float rinv = 1.0f / sqrtf(wave_sum(ss) * (1.0f / D) + EPS);
            const float* mb = MOD + (size_t)(p.ln * 3 + bsel) * 9216; const float* gp = normg + (size_t)(p.ln * 6 + p.gpre_i) * D;
#pragma unroll
            for (int j = 0; j < 4; ++j) { const int cc = 4 * lane + 256 * j; const f32x4 g = *(const f32x4*)(gp + cc), sh = *(const f32x4*)(mb + p.shift_i * D + cc), sc = *(const f32x4*)(mb + p.scale_i * D + cc);
                const f32x4 o = x[j] * rinv * g * (sc + 1.0f) + sh; u32x2 w; w.x = cvtpk(o.x, o.y); w.y = cvtpk(o.z, o.w);
                *(u32x2*)(XN + (size_t)r * D + cc) = w; }
        }
    }
}

__device__ __forceinline__ int pos_row(int b, int P) { return (P < CTXL) ? ML + b * CTXL + P : b * SEQ + (P - CTXL); }
__device__ __forceinline__ int chunk_row0(int b, int c) { return (c < 4) ? ML + b * CTXL + 64 * c : b * SEQ + 64 * (c - 4); }

__device__ __forceinline__ void wcm_item(const float* wqkv, const float* wg, bf16_t* wcm, int idx) {
    const int li = idx >> 15, c = (idx >> 4) & 2047, g = idx & 15, n = c >> 2, i = c & 3;
    const float* wq = wqkv + ((size_t)(li * 3 + 0) * 512 + n) * 16; const float* wk = wqkv + ((size_t)(li * 3 + 1) * 512 + n) * 16; const float* wv = wqkv + ((size_t)(li * 3 + 2) * 512 + n) * 16;
    const float* G = wg + (size_t)li * 6144 * 16;
    float sc = 0.f, sm = 0.f;
#pragma unroll
    for (int o = 0; o < 4; ++o) { sc += wq[o * 4 + i] * G[(size_t)(4 * n + o) * 16 + g] + wk[o * 4 + i] * G[(size_t)(2048 + 4 * n + o) * 16 + g]; sm += wv[o * 4 + i] * G[(size_t)(4096 + 4 * n + o) * 16 + g]; }
    const int ks = c >> 5, ln = ((c >> 3) & 3) * 16 + g, jj = c & 7;
    wcm[(((size_t)li * 128 + ks) * 64 + ln) * 8 + jj] = f2bf(sc); wcm[(((size_t)li * 128 + 64 + ks) * 64 + ln) * 8 + jj] = f2bf(sm);
}
__device__ __forceinline__ void gates_tile(const bf16_t* XC, const bf16_t* XM, const bf16_t* wcmb, const float* bg, float* GATES, int tile, int lane) {
    const int r0 = 16 * tile;
    const bf16_t* ac = XC + (size_t)(r0 + (lane & 15)) * DI + 8 * (lane >> 4); const bf16_t* am = XM + (size_t)(r0 + (lane & 15)) * DI + 8 * (lane >> 4);
    const bf16_t* bp = wcmb + (size_t)lane * 8;
    f32x4 acc0 = {0.f, 0.f, 0.f, 0.f}, acc1 = acc0;
#pragma unroll 4
    for (int ks = 0; ks < 64; ++ks) {
        const bf16x8 a0 = *(const bf16x8*)(ac + 32 * ks), b0 = *(const bf16x8*)(bp + (size_t)ks * 512), a1 = *(const bf16x8*)(am + 32 * ks), b1 = *(const bf16x8*)(bp + (size_t)(64 + ks) * 512);
        acc0 = mfma16(a0, b0, acc0); acc1 = mfma16(a1, b1, acc1); }
    const float bb = bg[lane & 15];
#pragma unroll
    for (int rg = 0; rg < 4; ++rg) GATES[(size_t)(r0 + 4 * (lane >> 4) + rg) * 16 + (lane & 15)] = acc0[rg] + acc1[rg] + bb;
}

__device__ __forceinline__ void phase_a2(const bf16_t* XM, bf16_t* XC, bf16_t* Q, bf16_t* K, bf16_t* V, const float* convw, const float* convb, const float* wqkv, int gw, int NGW, int lane) {
    asm volatile("" : "+v"(lane));
    for (int unit = gw; unit < R / 2; unit += NGW) {
        const int r0 = 2 * unit;
        int rowbase, gr, gc0, nr, nc;
        if (r0 < ML) { const int b = r0 >> 13, t0 = r0 & (SEQ - 1); rowbase = b * SEQ; gr = t0 >> 6; gc0 = t0 & 63; nr = SEQ / 64; nc = 64; }
        else { const int b = (r0 - ML) >> 8; rowbase = ML + b * CTXL; gr = 0; gc0 = (r0 - ML) & (CTXL - 1); nr = 1; nc = CTXL; }
#pragma unroll 1
        for (int j = 0; j < 4; ++j) {
            const int c0 = 512 * j + 8 * lane;
            float xcv[2][8], xmv[2][8];
            {
                float a[2][8];
                const f32x4 b0 = *(const f32x4*)(convb + c0), b1 = *(const f32x4*)(convb + c0 + 4);
#pragma unroll
                for (int tk = 0; tk < 2; ++tk) { a[tk][0] = b0.x; a[tk][1] = b0.y; a[tk][2] = b0.z; a[tk][3] = b0.w; a[tk][4] = b1.x; a[tk][5] = b1.y; a[tk][6] = b1.z; a[tk][7] = b1.w; }
#pragma unroll
                for (int dr = 0; dr < 3; ++dr) {
                    const int rr = gr + dr - 1; const bool rok = (rr >= 0) && (rr < nr);
                    float xt[4][8];
#pragma unroll
                    for (int dc = 0; dc < 4; ++dc) { const int cc = gc0 + dc - 1; const bool ok = rok && (cc >= 0) && (cc < nc);
                        u32x4 w = {0u, 0u, 0u, 0u}; if (ok) w = *(const u32x4*)(XM + (size_t)(rowbase + rr * nc + cc) * DI + c0);
                        xt[dc][0] = bflo(w.x); xt[dc][1] = bfhi(w.x); xt[dc][2] = bflo(w.y); xt[dc][3] = bfhi(w.y); xt[dc][4] = bflo(w.z); xt[dc][5] = bfhi(w.z); xt[dc][6] = bflo(w.w); xt[dc][7] = bfhi(w.w); }
                    if (dr == 1) {
#pragma unroll
                        for (int tk = 0; tk < 2; ++tk)
#pragma unroll
                            for (int e = 0; e < 8; ++e) xmv[tk][e] = xt[tk + 1][e];
                    }
#pragma unroll
                    for (int dc = 0; dc < 3; ++dc) {
                        const f32x4 w0 = *(const f32x4*)(convw + (size_t)(dr * 3 + dc) * DI + c0), w1 = *(const f32x4*)(convw + (size_t)(dr * 3 + dc) * DI + c0 + 4);
                        const float cw[8] = {w0.x, w0.y, w0.z, w0.w, w1.x, w1.y, w1.z, w1.w};
#pragma unroll
                        for (int tk = 0; tk < 2; ++tk)
#pragma unroll
                            for (int e = 0; e < 8; ++e) a[tk][e] += cw[e] * xt[tk + dc][e];
                    }
                }
#pragma unroll
                for (int tk = 0; tk < 2; ++tk)
#pragma unroll
                    for (int e = 0; e < 8; ++e) xcv[tk][e] = silu_f(a[tk][e]);
            }
#pragma unroll
            for (int tk = 0; tk < 2; ++tk) { u32x4 w; w.x = cvtpk(xcv[tk][0], xcv[tk][1]); w.y = cvtpk(xcv[tk][2], xcv[tk][3]); w.z = cvtpk(xcv[tk][4], xcv[tk][5]); w.w = cvtpk(xcv[tk][6], xcv[tk][7]);
                *(u32x4*)(XC + (size_t)(r0 + tk) * DI + c0) = w; }
#pragma unroll
            for (int part = 0; part < 3; ++part) {
                float wb[2][16];
#pragma unroll
                for (int bl = 0; bl < 2; ++bl)
#pragma unroll
                    for (int q4 = 0; q4 < 4; ++q4) { const f32x4 w = *(const f32x4*)(wqkv + ((size_t)part * 512 + (c0 >> 2) + bl) * 16 + 4 * q4); wb[bl][4 * q4] = w.x; wb[bl][4 * q4 + 1] = w.y; wb[bl][4 * q4 + 2] = w.z; wb[bl][4 * q4 + 3] = w.w; }
                bf16_t* dst = (part == 0) ? Q : (part == 1) ? K : V;
                const float osc = (part == 1) ? 0.04419417382415922f : 1.0f;
#pragma unroll
                for (int tk = 0; tk < 2; ++tk) {
                    float o8[8];
#pragma unroll
                    for (int bl = 0; bl < 2; ++bl)
#pragma unroll
                        for (int o = 0; o < 4; ++o) { float s = 0.f;
#pragma unroll
                            for (int i = 0; i < 4; ++i) s += wb[bl][o * 4 + i] * ((part == 2) ? xmv[tk][4 * bl + i] : xcv[tk][4 * bl + i]);
                            o8[4 * bl + o] = s * osc; }
                    u32x4 w; w.x = cvtpk(o8[0], o8[1]); w.y = cvtpk(o8[2], o8[3]); w.z = cvtpk(o8[4], o8[5]); w.w = cvtpk(o8[6], o8[7]);
                    *(u32x4*)(dst + (size_t)(r0 + tk) * DI + c0) = w;
                }
            }
        }
    }
}

__device__ __forceinline__ float wave_incl_sum(float v, int lane) {
#pragma unroll
    for (int o = 1; o < 64; o <<= 1) { const float t = __shfl_up(v, o); if (lane >= o) v += t; }
    return v;
}
__device__ __forceinline__ float wave_incl_max(float v, int lane) {
#pragma unroll
    for (int o = 1; o < 64; o <<= 1) { const float t = __shfl_up(v, o); if (lane >= o) v = fmaxf(v, t); }
    return v;
}
__device__ __forceinline__ float logsigmoid_f(float x) { return fminf(x, 0.f) - log1pf(__expf(-fabsf(x))); }
__device__ __forceinline__ int stream_chunk(int dir, int sc) { return dir ? ((sc < 4) ? 3 - sc : 135 - sc) : sc; }

__device__ __forceinline__ void gate_scan(const float* GATES, float* GM, LAS float* Bl, LAS float* Al, LAS float* tot, LAS float* mxs, int s, bool store_gm, int wave, int lane) {
    const int dir = s >> 3, b = (s >> 2) & 1, h = s & 3;
    for (int sc = wave; sc < NCHUNK; sc += NWAVES) {
        const int c = stream_chunk(dir, sc), P = 64 * c + (dir ? 63 - lane : lane), row = pos_row(b, P);
        const float gf = GATES[(size_t)row * 16 + (dir * 2 + 1) * 4 + h];
        const float ps = wave_incl_sum(logsigmoid_f(gf), lane);
        Bl[sc * 64 + lane] = ps; if (lane == 63) tot[sc] = ps;
    }
    __syncthreads();
    if (wave == 0) { float carry = 0.f;
        for (int i0 = 0; i0 < NCHUNK; i0 += 64) { const int i = i0 + lane; const float v = (i < NCHUNK) ? tot[i] : 0.f; const float inc = wave_incl_sum(v, lane);
            if (i < NCHUNK) tot[i] = carry + inc - v; carry += __shfl(inc, 63); } }
    __syncthreads();
    for (int sc = wave; sc < NCHUNK; sc += NWAVES) {
        const int c = stream_chunk(dir, sc), P = 64 * c + (dir ? 63 - lane : lane), row = pos_row(b, P);
        const float gi = GATES[(size_t)row * 16 + (dir * 2 + 0) * 4 + h];
        const float B = Bl[sc * 64 + lane] + tot[sc]; const float pm = wave_incl_max(gi - B, lane);
        Bl[sc * 64 + lane] = B; Al[sc * 64 + lane] = pm; if (lane == 63) mxs[sc] = pm;
    }
    __syncthreads();
    if (wave == 0) { float carry = 0.f;
        for (int i0 = 0; i0 < NCHUNK; i0 += 64) { const int i = i0 + lane; const float v = (i < NCHUNK) ? mxs[i] : -3.0e38f; const float inc = wave_incl_max(v, lane);
            float ex = __shfl_up(inc, 1); if (lane == 0) ex = -3.0e38f; ex = fmaxf(ex, carry);
            if (i < NCHUNK) mxs[i] = ex; carry = fmaxf(carry, __shfl(inc, 63)); } }
    __syncthreads();
    for (int sc = wave; sc < NCHUNK; sc += NWAVES) {
        const int c = stream_chunk(dir, sc), P = 64 * c + (dir ? 63 - lane : lane);
        const float m = Bl[sc * 64 + lane] + fmaxf(mxs[sc], Al[sc * 64 + lane]);
        Al[sc * 64 + lane] = m; if (store_gm) GM[(size_t)s * NPOS + P] = m;
    }
    __syncthreads();
}

__device__ __forceinline__ void phase_a3(const bf16_t* Q, bf16_t* K, bf16_t* V, bf16_t* SRAW, const bf16_t* XC, const bf16_t* XM, const bf16_t* wcmb, const float* bg, float* GATES, LAS unsigned char* lds, int vcu, int G, int tid, int wave, int lane) {
    asm volatile("" : "+v"(tid), "+v"(lane));
    constexpr int PITCH = 520;
    LAS bf16_t* tile = (LAS bf16_t*)lds;
    for (int t16 = vcu * NWAVES + wave; t16 < R / 16; t16 += G * NWAVES) gates_tile(XC, XM, wcmb, bg, GATES, t16, lane);
    for (int unit = vcu; unit < 8 * NCHUNK; unit += G) {
        const int bh = unit / NCHUNK, c = unit % NCHUNK, b = bh >> 2, h = bh & 3, row0 = chunk_row0(b, c);
        {
            const int tt = wave >> 1, st0 = 2 * (wave & 1);
            const bf16_t* qp = Q + (size_t)(row0 + 16 * tt + (lane & 15)) * DI + h * DH + 8 * (lane >> 4);
            const bf16_t* kp = K + (size_t)(row0 + 16 * st0 + (lane & 15)) * DI + h * DH + 8 * (lane >> 4);
            f32x4 acc0 = {0.f, 0.f, 0.f, 0.f}, acc1 = acc0;
#pragma unroll 4
            for (int ks = 0; ks < 16; ++ks) { const bf16x8 a = *(const bf16x8*)(qp + 32 * ks), b0 = *(const bf16x8*)(kp + 32 * ks), b1 = *(const bf16x8*)(kp + (size_t)16 * DI + 32 * ks);
                acc0 = mfma16(a, b0, acc0); acc1 = mfma16(a, b1, acc1); }
            bf16_t* sp = SRAW + (size_t)unit * 4096 + (16 * tt + 4 * (lane >> 4)) * 64 + 16 * st0 + (lane & 15);
#pragma unroll
            for (int rg = 0; rg < 4; ++rg) { sp[rg * 64] = f2bf(acc0[rg]); sp[rg * 64 + 16] = f2bf(acc1[rg]); }
        }
        __syncthreads();
#pragma unroll 1
        for (int which = 0; which < 2; ++which) {
            bf16_t* Xp = (which ? V : K) + (size_t)row0 * DI + h * DH;
#pragma unroll
            for (int i = 0; i < 8; ++i) { const int piece = tid + NTHREADS * i, s = piece >> 6, kc = piece & 63;
                *(LAS u32x4*)(tile + s * PITCH + 8 * kc) = *(const u32x4*)(Xp + (size_t)s * DI + 8 * kc); }
            __syncthreads();
#pragma unroll
            for (int i = 0; i < 8; ++i) { const int piece = tid + NTHREADS * i, sg = piece >> 9, k = piece & 511;
                unsigned short e[8];
#pragma unroll
                for (int q = 0; q < 8; ++q) e[q] = tile[(8 * sg + q) * PITCH + k];
                u32x4 w; w.x = e[0] | ((unsigned)e[1] << 16); w.y = e[2] | ((unsigned)e[3] << 16); w.z = e[4] | ((unsigned)e[5] << 16); w.w = e[6] | ((unsigned)e[7] << 16);
                *(u32x4*)(Xp + (size_t)(k >> 3) * DI + (k & 7) * 64 + 8 * sg) = w; }
            __syncthreads();
        }
    }
}

__device__ __forceinline__ void phase_a4(const bf16_t* Q, const bf16_t* KT, const bf16_t* VT, const bf16_t* SRAW, const float* GATES, float* GM, bf16_t* NUMF, bf16_t* NUMB, float* PD,
                                         LAS unsigned char* lds, int vcu, int tid, int wave, int lane) {
    asm volatile("" : "+v"(tid), "+v"(lane));
    constexpr int CP = 520, SP = 72;
    LAS bf16_t* CtL = (LAS bf16_t*)lds;
    LAS bf16_t* SdL = CtL + 32 * CP;
    LAS bf16_t* VtL = SdL + 64 * SP;
    LAS bf16_t* VwL = VtL + 32 * SP;
    LAS float* Bs = (LAS float*)(VwL + 32 * SP);
    LAS float* ms = Bs + 64; LAS float* is_ = ms + 64; LAS float* sci = is_ + 64; LAS float* wsv = sci + 64; LAS float* nL = wsv + 64;
    LAS float* Bl = nL + 64; LAS float* Ml = Bl + NPOS; LAS float* tot = Ml + NPOS; LAS float* mxs = tot + 192;
    const int s = vcu >> 4, j = vcu & 15, dir = s >> 3, b = (s >> 2) & 1, h = s & 3;
    gate_scan(GATES, GM, Bl, Ml, tot, mxs, s, j == 0, wave, lane);
    bf16_t* NUM = dir ? NUMB : NUMF;
    const int tt = wave >> 1, vt = wave & 1;
    f32x4 cacc[4][2];
#pragma unroll
    for (int kt = 0; kt < 4; ++kt)
#pragma unroll
        for (int v2 = 0; v2 < 2; ++v2) cacc[kt][v2] = (f32x4){0.f, 0.f, 0.f, 0.f};
    for (int i = tid; i < 32 * CP / 2; i += NTHREADS) ((LAS unsigned*)CtL)[i] = 0u;
    if (tid < 32) nL[tid] = 0.f;
    float Bprev = 0.f, mprev = 0.f;
    __syncthreads();
#pragma unroll 1
    for (int step = 0; step < NCHUNK; ++step) {
        const int c = stream_chunk(dir, step), row0 = chunk_row0(b, c);
        if (tid < 64) { const int sp = step * 64 + (dir ? 63 - tid : tid); Bs[tid] = Bl[sp]; ms[tid] = Ml[sp]; is_[tid] = GATES[(size_t)(row0 + tid) * 16 + dir * 8 + h]; }
        __syncthreads();
        const int il = dir ? 0 : 63;
        const float Blast = Bs[il], mlast = ms[il];
        const float decay = __expf(Blast - Bprev + mprev - mlast);
        if (tid < 64) { sci[tid] = __expf(Bs[tid] - Bprev + mprev - ms[tid]); wsv[tid] = __expf(Blast - Bs[tid] + is_[tid] - mlast); }
        float rs;
        {
            const int t = tid >> 3, s0 = 8 * (tid & 7);
            const u32x4 w = *(const u32x4*)(SRAW + ((size_t)((b * 4 + h) * NCHUNK + c)) * 4096 + t * 64 + s0);
            const float sv[8] = {bflo(w.x), bfhi(w.x), bflo(w.y), bfhi(w.y), bflo(w.z), bfhi(w.z), bflo(w.w), bfhi(w.w)};
            const float Bt = Bs[t], mt = ms[t];
            float d[8]; float acc = 0.f;
#pragma unroll
            for (int e = 0; e < 8; ++e) { const int ss = s0 + e; const bool ok = dir ? (ss >= t) : (ss <= t);
                d[e] = ok ? sv[e] * __expf(Bt - Bs[ss] + is_[ss] - mt) : 0.f; acc += d[e]; }
            u32x4 o; o.x = cvtpk(d[0], d[1]); o.y = cvtpk(d[2], d[3]); o.z = cvtpk(d[4], d[5]); o.w = cvtpk(d[6], d[7]);
            *(LAS u32x4*)(SdL + t * SP + s0) = o;
            acc += __shfl_xor(acc, 1); acc += __shfl_xor(acc, 2); acc += __shfl_xor(acc, 4); rs = acc;
        }
        __syncthreads();
        if (tid < 256) {
            const int v = tid >> 3, s0 = 8 * (tid & 7), vv = 32 * j + v;
            const u32x4 w = *(const u32x4*)(VT + (size_t)(row0 + (vv >> 3)) * DI + h * DH + (vv & 7) * 64 + s0);
            *(LAS u32x4*)(VtL + v * SP + s0) = w;
            u32x4 o; o.x = cvtpk(bflo(w.x) * wsv[s0], bfhi(w.x) * wsv[s0 + 1]); o.y = cvtpk(bflo(w.y) * wsv[s0 + 2], bfhi(w.y) * wsv[s0 + 3]);
            o.z = cvtpk(bflo(w.z) * wsv[s0 + 4], bfhi(w.z) * wsv[s0 + 5]); o.w = cvtpk(bflo(w.w) * wsv[s0 + 6], bfhi(w.w) * wsv[s0 + 7]);
            *(LAS u32x4*)(VwL + v * SP + s0) = o;
        }
        __syncthreads();
        {
            f32x4 a1 = {0.f, 0.f, 0.f, 0.f}, a2 = a1;
            const bf16_t* qp = Q + (size_t)(row0 + 16 * tt + (lane & 15)) * DI + h * DH + 8 * (lane >> 4);
            const LAS bf16_t* cp = CtL + (16 * vt + (lane & 15)) * CP + 8 * (lane >> 4);
#pragma unroll 4
            for (int ks = 0; ks < 16; ++ks) { const bf16x8 a = *(const bf16x8*)(qp + 32 * ks); const bf16x8 bb = *(const LAS bf16x8*)(cp + 32 * ks); a1 = mfma16(a, bb, a1); }
#pragma unroll
            for (int ks = 0; ks < 2; ++ks) { const bf16x8 a = *(const LAS bf16x8*)(SdL + (16 * tt + (lane & 15)) * SP + 32 * ks + 8 * (lane >> 4));
                const bf16x8 bb = *(const LAS bf16x8*)(VtL + (16 * vt + (lane & 15)) * SP + 32 * ks + 8 * (lane >> 4)); a2 = mfma16(a, bb, a2); }
            bf16_t* op = NUM + (size_t)(row0 + 16 * tt + 4 * (lane >> 4)) * DI + h * DH + 32 * j + 16 * vt + (lane & 15);
#pragma unroll
            for (int rg = 0; rg < 4; ++rg) op[(size_t)rg * DI] = f2bf(sci[16 * tt + 4 * (lane >> 4) + rg] * a1[rg] + a2[rg]);
        }
        {
            const int t = tid >> 3, kq = tid & 7;
            const u32x2 w = *(const u32x2*)(Q + (size_t)(row0 + t) * DI + h * DH + 32 * j + 4 * kq);
            float acc = bflo(w.x) * nL[4 * kq] + bfhi(w.x) * nL[4 * kq + 1] + bflo(w.y) * nL[4 * kq + 2] + bfhi(w.y) * nL[4 * kq + 3];
            acc += __shfl_xor(acc, 1); acc += __shfl_xor(acc, 2); acc += __shfl_xor(acc, 4);
            if (kq == 0) PD[((size_t)s * 16 + j) * NPOS + 64 * c + t] = sci[t] * acc + ((j == 0) ? rs : 0.f);
        }
        __syncthreads();
#pragma unroll
        for (int kt = 0; kt < 4; ++kt)
#pragma unroll
            for (int v2 = 0; v2 < 2; ++v2) cacc[kt][v2] *= decay;
#pragma unroll
        for (int ks = 0; ks < 2; ++ks) {
            bf16x8 bw[2];
#pragma unroll
            for (int v2 = 0; v2 < 2; ++v2) bw[v2] = *(const LAS bf16x8*)(VwL + (16 * v2 + (lane & 15)) * SP + 32 * ks + 8 * (lane >> 4));
#pragma unroll
            for (int kt = 0; kt < 4; ++kt) { const int k = 64 * wave + 16 * kt + (lane & 15);
                const bf16x8 a = *(const bf16x8*)(KT + (size_t)(row0 + (k >> 3)) * DI + h * DH + (k & 7) * 64 + 32 * ks + 8 * (lane >> 4));
#pragma unroll
                for (int v2 = 0; v2 < 2; ++v2) cacc[kt][v2] = mfma16(a, bw[v2], cacc[kt][v2]); }
        }
#pragma unroll
        for (int kt = 0; kt < 4; ++kt)
#pragma unroll
            for (int v2 = 0; v2 < 2; ++v2) { u32x2 o; o.x = cvtpk(cacc[kt][v2][0], cacc[kt][v2][1]); o.y = cvtpk(cacc[kt][v2][2], cacc[kt][v2][3]);
                *(LAS u32x2*)(CtL + (16 * v2 + (lane & 15)) * CP + 64 * wave + 16 * kt + 4 * (lane >> 4)) = o; }
        {
            const int kk = tid >> 4, sq = tid & 15, k = 32 * j + kk;
            const u32x2 w = *(const u32x2*)(KT + (size_t)(row0 + (k >> 3)) * DI + h * DH + (k & 7) * 64 + 4 * sq);
            float acc = bflo(w.x) * wsv[4 * sq] + bfhi(w.x) * wsv[4 * sq + 1] + bflo(w.y) * wsv[4 * sq + 2] + bfhi(w.y) * wsv[4 * sq + 3];
            acc += __shfl_xor(acc, 1); acc += __shfl_xor(acc, 2); acc += __shfl_xor(acc, 4); acc += __shfl_xor(acc, 8);
            if (sq == 0) nL[kk] = decay * nL[kk] + acc;
        }
        Bprev = Blast; mprev = mlast;
        __syncthreads();
    }
}

__device__ __forceinline__ void phase_a5(const bf16_t* NUMF, const bf16_t* NUMB, const float* PD, const float* GM, const bf16_t* XC, const bf16_t* Z, bf16_t* G, const float* ang, const float* askip, int gw, int NGW, int lane) {
    asm volatile("" : "+v"(lane));
    for (int r = gw; r < R; r += NGW) {
        int b, P; if (r < ML) { b = r >> 13; P = CTXL + (r & (SEQ - 1)); } else { b = (r - ML) >> 8; P = (r - ML) & (CTXL - 1); }
#pragma unroll 1
        for (int h = 0; h < 4; ++h) {
            const int sf = b * 4 + h, sb = 8 + b * 4 + h;
            float df = 0.f, db = 0.f;
#pragma unroll
            for (int jj = 0; jj < 16; ++jj) { df += PD[((size_t)sf * 16 + jj) * NPOS + P]; db += PD[((size_t)sb * 16 + jj) * NPOS + P]; }
            const float nf = 1.0f / fmaxf(fabsf(df), __expf(-GM[(size_t)sf * NPOS + P])), nb = 1.0f / fmaxf(fabsf(db), __expf(-GM[(size_t)sb * NPOS + P]));
            const int c0 = h * DH + 8 * lane;
            const u32x4 wf = *(const u32x4*)(NUMF + (size_t)r * DI + c0), wb = *(const u32x4*)(NUMB + (size_t)r * DI + c0);
            float hv[8] = {bflo(wf.x) * nf + bflo(wb.x) * nb, bfhi(wf.x) * nf + bfhi(wb.x) * nb, bflo(wf.y) * nf + bflo(wb.y) * nb, bfhi(wf.y) * nf + bfhi(wb.y) * nb,
                           bflo(wf.z) * nf + bflo(wb.z) * nb, bfhi(wf.z) * nf + bfhi(wb.z) * nb, bflo(wf.w) * nf + bflo(wb.w) * nb, bfhi(wf.w) * nf + bfhi(wb.w) * nb};
            float sm = 0.f;
#pragma unroll
            for (int e = 0; e < 8; ++e) sm += hv[e];
            const float mu = wave_sum(sm) * (1.0f / DH); float sq = 0.f;
#pragma unroll
            for (int e = 0; e < 8; ++e) { hv[e] -= mu; sq += hv[e] * hv[e]; }
            const float rstd = 1.0f / sqrtf(wave_sum(sq) * (1.0f / DH) + EPS);
            const u32x4 wx = *(const u32x4*)(XC + (size_t)r * DI + c0), wz = *(const u32x4*)(Z + (size_t)r * DI + c0);
            const float xc[8] = {bflo(wx.x), bfhi(wx.x), bflo(wx.y), bfhi(wx.y), bflo(wx.z), bfhi(wx.z), bflo(wx.w), bfhi(wx.w)};
            const float zz[8] = {bflo(wz.x), bfhi(wz.x), bflo(wz.y), bfhi(wz.y), bflo(wz.z), bfhi(wz.z), bflo(wz.w), bfhi(wz.w)};
            const f32x4 g0 = *(const f32x4*)(ang + c0), g1 = *(const f32x4*)(ang + c0 + 4), k0 = *(const f32x4*)(askip + c0), k1 = *(const f32x4*)(askip + c0 + 4);
            const float gg[8] = {g0.x, g0.y, g0.z, g0.w, g1.x, g1.y, g1.z, g1.w}, kk[8] = {k0.x, k0.y, k0.z, k0.w, k1.x, k1.y, k1.z, k1.w};
            float o[8];
#pragma unroll
            for (int e = 0; e < 8; ++e) o[e] = (hv[e] * rstd * gg[e] + kk[e] * xc[e]) * silu_f(zz[e]);
            u32x4 w; w.x = cvtpk(o[0], o[1]); w.y = cvtpk(o[2], o[3]); w.z = cvtpk(o[4], o[5]); w.w = cvtpk(o[6], o[7]);
            *(u32x4*)(G + (size_t)r * DI + c0) = w;
        }
    }
}

__device__ __forceinline__ void phase_g2(bf16_t* U, const bf16_t* V, const float* vst, const float* lng, const float* lnb, const float* Ws, const float* bs, LAS unsigned char* lds, int vcu, int G, int tid, int wave, int lane) {
    asm volatile("" : "+v"(tid), "+v"(lane));
    constexpr int VP = 136;
    LAS bf16_t* VT = (LAS bf16_t*)lds;
    LAS float* mu = (LAS float*)(VT + 384 * VP); LAS float* rsd = mu + 128;
    for (int unit = vcu; unit < (R / 128) * 8; unit += G) {
        const int c = unit >> 3, g = unit & 7, r0 = 128 * c, e0 = 384 * g;
        if (tid < 128) { float s = 0.f, q = 0.f; const float* p = vst + (size_t)(r0 + tid) * 96;
#pragma unroll 8
            for (int i = 0; i < 48; ++i) { const f32x2 v = *(const f32x2*)(p + 2 * i); s += v.x; q += v.y; }
            const float m = s * (1.0f / EH); const float var = fmaxf(q * (1.0f / EH) - m * m, 0.f); mu[tid] = m; rsd[tid] = 1.0f / sqrtf(var + EPS); }
        __syncthreads();
#pragma unroll 1
        for (int i = 0; i < 12; ++i) { const int piece = tid + NTHREADS * i, q = piece & 127, ep = piece >> 7;
            const u32x4 w = *(const u32x4*)(V + (size_t)(r0 + q) * EH + e0 + 8 * ep);
            const f32x4 g0 = *(const f32x4*)(lng + e0 + 8 * ep), g1 = *(const f32x4*)(lng + e0 + 8 * ep + 4), b0 = *(const f32x4*)(lnb + e0 + 8 * ep), b1 = *(const f32x4*)(lnb + e0 + 8 * ep + 4);
            const float m = mu[q], rr = rsd[q];
            const float v[8] = {bflo(w.x), bfhi(w.x), bflo(w.y), bfhi(w.y), bflo(w.z), bfhi(w.z), bflo(w.w), bfhi(w.w)};
            const float gg[8] = {g0.x, g0.y, g0.z, g0.w, g1.x, g1.y, g1.z, g1.w}, bb[8] = {b0.x, b0.y, b0.z, b0.w, b1.x, b1.y, b1.z, b1.w};
#pragma unroll
            for (int e = 0; e < 8; ++e) VT[(8 * ep + e) * VP + q] = f2bf((v[e] - m) * rr * gg[e] + bb[e]); }
        __syncthreads();
        bf16x8 bfr[4];
        { const float* wp = Ws + ((size_t)g * 128 + 16 * wave + (lane & 15)) * 128 + 8 * (lane >> 4);
#pragma unroll
          for (int ks = 0; ks < 4; ++ks) { const f32x4 w0 = *(const f32x4*)(wp + 32 * ks), w1 = *(const f32x4*)(wp + 32 * ks + 4);
              u32x4 pk; pk.x = cvtpk(w0.x, w0.y); pk.y = cvtpk(w0.z, w0.w); pk.z = cvtpk(w1.x, w1.y); pk.w = cvtpk(w1.z, w1.w); bfr[ks] = __builtin_bit_cast(bf16x8, pk); } }
        const int p = 16 * wave + (lane & 15); const float bsp = bs[g * 128 + p];
        bf16_t* up = U + (size_t)(r0 + p) * EH + e0 + 4 * (lane >> 4);
#pragma unroll 2
        for (int et = 0; et < 24; ++et) {
            f32x4 acc = {0.f, 0.f, 0.f, 0.f};
#pragma unroll
            for (int ks = 0; ks < 4; ++ks) { const bf16x8 a = *(const LAS bf16x8*)(VT + (16 * et + (lane & 15)) * VP + 32 * ks + 8 * (lane >> 4)); acc = mfma16(a, bfr[ks], acc); }
            const u32x2 uw = *(const u32x2*)(up + 16 * et);
            u32x2 o; o.x = cvtpk(bflo(uw.x) * (acc[0] + bsp), bfhi(uw.x) * (acc[1] + bsp)); o.y = cvtpk(bflo(uw.y) * (acc[2] + bsp), bfhi(uw.y) * (acc[3] + bsp));
            *(u32x2*)(up + 16 * et) = o;
        }
        __syncthreads();
    }
}

#ifndef MK_PER_PHASE
#define MK_PER_PHASE 0
#endif
constexpr int N_STEPS = 2 + 8 * 3 + 2 * 7 + 2 * 4;
struct Args { const float* in[26]; float* out; unsigned char* ws; int ph_lo, ph_hi; };

__global__ void __launch_bounds__(NTHREADS, 2) mk_fwd(Args args) {
    extern __shared__ __attribute__((aligned(16))) unsigned char lds_raw[];
    LAS unsigned char* lds = (LAS unsigned char*)lds_raw;
    const int tid = threadIdx.x, lane = tid & 63, wave = __builtin_amdgcn_readfirstlane(tid >> 6);
    const int G = gridDim.x; const int bx = blockIdx.x; const int vcu = (G % 8 == 0) ? (bx % 8) * (G / 8) + bx / 8 : bx;
    const int gw = vcu * NWAVES + wave, NGW = G * NWAVES;
    LAS unsigned long long* PT = (LAS unsigned long long*)(lds + LDSCTL_OFF + 1024);
    for (int u = tid; u < (LDS_BYTES - LDSCTL_OFF) / 4; u += NTHREADS) ((LAS unsigned*)(lds + LDSCTL_OFF))[u] = 0u;
    __syncthreads();
    if (tid == 0) {
#define PT_SET(i) PT[i] = (unsigned long long)args.in[i];
        PT_SET(0) PT_SET(1) PT_SET(2) PT_SET(3) PT_SET(4) PT_SET(5) PT_SET(6) PT_SET(7) PT_SET(8) PT_SET(9) PT_SET(10) PT_SET(11) PT_SET(12) PT_SET(13)
        PT_SET(14) PT_SET(15) PT_SET(16) PT_SET(17) PT_SET(18) PT_SET(19) PT_SET(20) PT_SET(21) PT_SET(22) PT_SET(23) PT_SET(24) PT_SET(25)
#undef PT_SET
        PT[26] = (unsigned long long)args.out; PT[27] = (unsigned long long)args.ws;
    }
    __syncthreads();
    const int lo = args.ph_lo, hi = args.ph_hi;
    XcdBarrier bar; bar.bar = (unsigned*)(args.ws + WS_CTL) + CW_BAR; bar.x = 0; bar.st = nullptr;
    if (hi - lo > 1) bar = xcd_barrier_post((unsigned*)(args.ws + WS_CTL) + CW_BAR, (volatile LAS unsigned*)(lds + MISC_OFF) + 8);
#define PTRU(i) ((unsigned long long)(unsigned)__builtin_amdgcn_readfirstlane((int)(unsigned)(PT[i] & 0xffffffffull)) | ((unsigned long long)(unsigned)__builtin_amdgcn_readfirstlane((int)(unsigned)(PT[i] >> 32)) << 32))
#define INP(i) ((const float*)PTRU(i))
#define WSB ((unsigned char*)PTRU(27))
#define x_in INP(0)
#define c_in INP(1)
#define ctx_in INP(2)
#define cctx_in INP(3)
#define w_ada INP(4)
#define b_ada INP(5)
#define normg INP(6)
#define X ((float*)PTRU(26))
#define CTXS ((float*)(ws + WS_CTXS))
#define MOD ((float*)(ws + WS_MOD))
#define XN ((bf16_t*)(ws + WS_XN))
#define Y ((bf16_t*)(ws + WS_Y))
#define WFI ((bf16_t*)(ws + WS_WFI))
#define WFO ((bf16_t*)(ws + WS_WFO))
#define WAI ((bf16_t*)(ws + WS_WAI))
#define WAO ((bf16_t*)(ws + WS_WAO))
#define WBI ((bf16_t*)(ws + WS_WBI))
#define WBO ((bf16_t*)(ws + WS_WBO))
#define WCM ((bf16_t*)(ws + WS_WCM))

    int step = 0;
#define RUN (step >= lo && step < hi)
#define ENDSTEP do { if (RUN && step + 1 < hi) xcd_barrier(bar); ++step; } while (0)

    if (RUN) { unsigned char* const ws = WSB;
        if (vcu < 144) adaln_unit(c_in, cctx_in, w_ada, b_ada, MOD, lds, vcu, tid, wave, lane);
        for (int i = vcu * NTHREADS + tid; i < 2 * 2048 * 16; i += G * NTHREADS) wcm_item(INP(12), INP(13), WCM, i);
        LAS float* scr = (LAS float*)(lds + wave * 16384);
        constexpr int I_FI = 16 * 176, I_FO = 44 * 32, I_AI = 16 * 128, I_AO = 32 * 32, I_BI = 16 * 192, I_BO = 48 * 32;
        constexpr int T_FI = 8 * I_FI, T_FO = T_FI + 8 * I_FO, T_AI = T_FO + 2 * I_AI, T_AO = T_AI + 2 * I_AO, T_BI = T_AO + 2 * I_BI, T_BO = T_BI + 2 * I_BO;
        for (int it = gw; it < T_BO; it += NGW) {
            if (it < T_FI) { const int m = it / I_FI, r = it % I_FI; p0_transpose_item(INP(7) + (size_t)m * D * 2 * DFF, D, 2 * DFF, WFI + (size_t)m * 2 * DFF * D, 1, scr, r, lane); }
            else if (it < T_FO) { const int q = it - T_FI, m = q / I_FO, r = q % I_FO; p0_transpose_item(INP(8) + (size_t)m * DFF * D, DFF, D, WFO + (size_t)m * D * DFF, 0, scr, r, lane); }
            else if (it < T_AI) { const int q = it - T_FO, m = q / I_AI, r = q % I_AI; p0_transpose_item(INP(9) + (size_t)m * D * 2 * DI, D, 2 * DI, WAI + (size_t)m * 2 * DI * D, 0, scr, r, lane); }
            else if (it < T_AO) { const int q = it - T_AI, m = q / I_AO, r = q % I_AO; p0_transpose_item(INP(17) + (size_t)m * DI * D, DI, D, WAO + (size_t)m * D * DI, 0, scr, r, lane); }
            else if (it < T_BI) { const int q = it - T_AO, m = q / I_BI, r = q % I_BI; p0_transpose_item(INP(18) + (size_t)m * D * 2 * EH, D, 2 * EH, WBI + (size_t)m * 2 * EH * D, 0, scr, r, lane); }
            else { const int q = it - T_BI, m = q / I_BO, r = q % I_BO; p0_transpose_item(INP(24) + (size_t)m * EH * D, EH, D, WBO + (size_t)m * D * EH, 0, scr, r, lane); }
        }
        __syncthreads();
    }
    ENDSTEP;
    if (RUN) { unsigned char* const ws = WSB; const ThinP p{1, 0, 0, 0, 0, 0.f, 1, 0, 0, 0, 1}; thin_phase(p, x_in, ctx_in, X, CTXS, Y, XN, MOD, normg, gw, NGW, lane); }
    ENDSTEP;

#pragma unroll 1
    for (int sb = 0; sb < 12; ++sb) {
        const int layer = sb / 3, sub = sb % 3, li = layer >> 1;
        const int kind = (sub != 1) ? 0 : ((layer & 1) ? 2 : 1);
        const int f = sub >> 1;
        if (kind == 0) {
            if (RUN) { unsigned char* const ws = WSB; pg8::Gemm g{XN, WFI + (size_t)(layer * 2 + f) * 2 * DFF * D, R, 2 * DFF, D}; pg8::StaticOrder S; S.init(R, 2 * DFF, G, bx);
                EpiSwiGLU E{(bf16_t*)(ws + WS_H), DFF}; pg8::gemm_phase<EpiSwiGLU, pg8::StaticOrder, PG8_ALIGN, PG8_SP2>(lds, g, S, E); }
            ENDSTEP;
        } else if (kind == 1) {
            if (RUN) { unsigned char* const ws = WSB; pg8::Gemm g{XN, WAI + (size_t)li * 2 * DI * D, R, 2 * DI, D}; pg8::StaticOrder S; S.init(R, 2 * DI, G, bx);
                pg8::EpiBf16<0> E{(bf16_t*)(ws + WS_XM), DI, nullptr, DI, (size_t)(WS_Z - WS_XM) / 2, 1.f}; pg8::gemm_phase<pg8::EpiBf16<0>, pg8::StaticOrder, PG8_ALIGN, PG8_SP2>(lds, g, S, E); }
            ENDSTEP;
            if (RUN) { unsigned char* const ws = WSB; phase_a2((const bf16_t*)(ws + WS_XM), (bf16_t*)(ws + WS_XC), (bf16_t*)(ws + WS_Q), (bf16_t*)(ws + WS_K), (bf16_t*)(ws + WS_VV),
                              INP(10) + (size_t)li * 9 * DI, INP(11) + (size_t)li * DI, INP(12) + (size_t)li * 3 * 512 * 16, gw, NGW, lane); }
            ENDSTEP;
            if (RUN) { unsigned char* const ws = WSB;
                phase_a3((const bf16_t*)(ws + WS_Q), (bf16_t*)(ws + WS_K), (bf16_t*)(ws + WS_VV), (bf16_t*)(ws + WS_SRAW), (const bf16_t*)(ws + WS_XC), (const bf16_t*)(ws + WS_XM), WCM + (size_t)li * 128 * 512, INP(14) + li * 16,
                         (float*)(ws + WS_GATES), lds, vcu, G, tid, wave, lane);
            }
            ENDSTEP;
            if (RUN) { unsigned char* const ws = WSB; if (G == 256) phase_a4((const bf16_t*)(ws + WS_Q), (const bf16_t*)(ws + WS_K), (const bf16_t*)(ws + WS_VV), (const bf16_t*)(ws + WS_SRAW), (const float*)(ws + WS_GATES), (float*)(ws + WS_GM),
                                (bf16_t*)(ws + WS_NUMF), (bf16_t*)(ws + WS_NUMB), (float*)(ws + WS_PD), lds, vcu, tid, wave, lane); }
            ENDSTEP;
            if (RUN) { unsigned char* const ws = WSB; phase_a5((const bf16_t*)(ws + WS_NUMF), (const bf16_t*)(ws + WS_NUMB), (const float*)(ws + WS_PD), (const float*)(ws + WS_GM), (const bf16_t*)(ws + WS_XC), (const bf16_t*)(ws + WS_Z),
                              (bf16_t*)(ws + WS_G), INP(15) + (size_t)li * DI, INP(16) + (size_t)li * DI, gw, NGW, lane); }
            ENDSTEP;
        } else {
            if (RUN) { unsigned char* const ws = WSB; pg8::Gemm g{XN, WBI + (size_t)li * 2 * EH * D, R, 2 * EH, D}; pg8::StaticOrder S; S.init(R, 2 * EH, G, bx);
                EpiGeluUV E{(bf16_t*)(ws + WS_U), (bf16_t*)(ws + WS_V), INP(19) + (size_t)li * 2 * EH, (float*)(ws + WS_VST)}; pg8::gemm_phase<EpiGeluUV, pg8::StaticOrder, PG8_ALIGN, PG8_SP2>(lds, g, S, E); }
            ENDSTEP;
            if (RUN) { unsigned char* const ws = WSB; phase_g2((bf16_t*)(ws + WS_U), (const bf16_t*)(ws + WS_V), (const float*)(ws + WS_VST), INP(20) + (size_t)li * EH, INP(21) + (size_t)li * EH,
                              INP(22) + (size_t)li * 8 * 128 * 128, INP(23) + (size_t)li * 8 * 128, lds, vcu, G, tid, wave, lane); }
            ENDSTEP;
        }
        if (RUN) { unsigned char* const ws = WSB;
            const bf16_t* A = (kind == 0) ? (const bf16_t*)(ws + WS_H) : (kind == 1) ? (const bf16_t*)(ws + WS_G) : (const bf16_t*)(ws + WS_U);
            const bf16_t* Bt = (kind == 0) ? WFO + (size_t)(layer * 2 + f) * D * DFF : (kind == 1) ? WAO + (size_t)li * D * DI : WBO + (size_t)li * D * EH;
            const int K = (kind == 0) ? DFF : (kind == 1) ? DI : EH;
            const float* bias = (kind == 2) ? INP(25) + (size_t)li * D : nullptr;
            pg8::Gemm g{A, Bt, R, D, K}; pg8::StaticOrder S; S.init(R, D, G, bx);
            pg8::EpiBf16<0> E{Y, D, bias, 0, 0, 1.f}; pg8::gemm_phase<pg8::EpiBf16<0>, pg8::StaticOrder, PG8_ALIGN, PG8_SP2>(lds, g, S, E);
        }
        ENDSTEP;
        if (RUN) { unsigned char* const ws = WSB;
            ThinP p;
            p.first = 0; p.has_y = 1; p.lp = layer;
            if (sub == 0) { p.gate_i = 2; p.gpost_i = 1; p.wgt = 0.5f; p.has_next = 1; p.ln = layer; p.gpre_i = 2; p.shift_i = 3; p.scale_i = 4; }
            else if (sub == 1) { p.gate_i = 5; p.gpost_i = 3; p.wgt = 1.0f; p.has_next = 1; p.ln = layer; p.gpre_i = 4; p.shift_i = 6; p.scale_i = 7; }
            else { p.gate_i = 8; p.gpost_i = 5; p.wgt = 0.5f; p.has_next = (layer < DEPTH - 1) ? 1 : 0; p.ln = (layer < DEPTH - 1) ? layer + 1 : layer; p.gpre_i = 0; p.shift_i = 0; p.scale_i = 1; }
            thin_phase(p, x_in, ctx_in, X, CTXS, Y, XN, MOD, normg, gw, NGW, lane);
        }
        ENDSTEP;
    }
#undef RUN
#undef ENDSTEP
#undef x_in
#undef c_in
#undef ctx_in
#undef cctx_in
#undef w_ada
#undef b_ada
#undef normg
#undef X
#undef CTXS
#undef MOD
#undef XN
#undef Y
#undef WFI
#undef WFO
#undef WAI
#undef WAO
#undef WBI
#undef WBO
#undef WCM
}
}

extern "C" void kernel_launch(void* const* d_in, const int* in_sizes, int n_in, void* d_out, int out_size, void* d_ws, size_t ws_size, hipStream_t stream) {
    using namespace mk;
    static int grid = 0;
    if (grid == 0) {
        if (n_in != 26 || out_size != ML * D || ws_size < WS_END) { fprintf(stderr, "kernel_launch: unexpected shapes (n_in %d, out %d, ws %zu < %zu); nothing launched\n", n_in, out_size, ws_size, (size_t)WS_END); grid = -1; return; }
        int dev = 0, cus = 0, per_cu = 0;
        if (hipGetDevice(&dev) != hipSuccess || hipDeviceGetAttribute(&cus, hipDeviceAttributeMultiprocessorCount, dev) != hipSuccess) { grid = -1; return; }
        if (hipFuncSetAttribute((const void*)mk_fwd, hipFuncAttributeMaxDynamicSharedMemorySize, LDS_BYTES) != hipSuccess) { fprintf(stderr, "kernel_launch: hipFuncSetAttribute failed\n"); grid = -1; return; }
        if (hipOccupancyMaxActiveBlocksPerMultiprocessor(&per_cu, (const void*)mk_fwd, NTHREADS, LDS_BYTES) != hipSuccess || per_cu < 1) { fprintf(stderr, "kernel_launch: occupancy query says %d\n", per_cu); }
        (void)hipGetLastError();
        grid = cus;
        if (grid != 256) { fprintf(stderr, "kernel_launch: this kernel is built for 256 CUs, found %d\n", grid); }
    }
    if (grid < 0) return;
    (void)hipMemsetAsync((char*)d_ws + WS_CTL, 0, CTL_ZERO_BYTES, stream);
    Args a{};
    for (int i = 0; i < 26; ++i) a.in[i] = (const float*)d_in[i];
    a.out = (float*)d_out; a.ws = (unsigned char*)d_ws;
#if MK_PER_PHASE
    for (int s = 0; s < N_STEPS; ++s) { a.ph_lo = s; a.ph_hi = s + 1; hipLaunchKernelGGL(mk_fwd, dim3(grid), dim3(NTHREADS), LDS_BYTES, stream, a); }
#else
    a.ph_lo = 0; a.ph_hi = N_STEPS; hipLaunchKernelGGL(mk_fwd, dim3(grid), dim3(NTHREADS), LDS_BYTES, stream, a);
#endif
}
```

```cpp
#include <hip/hip_runtime.h>
#include <cstdio>
#include <cstdint>
namespace pg8 {
#define PG8_LAS __attribute__((address_space(3)))
typedef unsigned short bf16_t;
typedef short bf16x8 __attribute__((ext_vector_type(8)));
typedef float f32x4 __attribute__((ext_vector_type(4)));
typedef unsigned u32x4 __attribute__((ext_vector_type(4)));
constexpr int BM = 256, BK = 64, HALF = 128, HTB = HALF * BK * 2  , STAGE_BYTES = 8 * HTB, NXCD = 8, WGM = 8;

__host__ __device__ __forceinline__ int lds_byte(int r, int c) { const int st = (r >> 4) * 2 + (c >> 5), rr = r & 15, cc = c & 31, ob = rr * 64 + cc * 2; return st * 1024 + (ob ^ (((ob >> 9) & 1) << 5)); }
__host__ __device__ __forceinline__ void stage_rc(int b, int& R, int& C) { const int st = b / 1024, sb = b % 1024, swz = sb ^ (((sb >> 9) & 1) << 5); R = (st >> 1) * 16 + swz / 64; C = (st & 1) * 32 + (swz % 64) / 2; }
__host__ __device__ __forceinline__ int perm32(int rho) { const int n = rho >> 4, i = rho & 15; return 8 * (i >> 2) + 4 * n + (i & 3); }

struct Unit { int pm, pn, kz, nt; };
struct Gemm { const bf16_t* A; const bf16_t* Bt; int M, N, K, ld; };

struct StaticOrder {
    int nM, nN, nwg, G, c;
    __host__ __device__ void init(int M, int N, int G_, int c_) { nM = M / BM; nN = N / BM; nwg = nM * nN; G = G_; c = c_; }
    __host__ __device__ bool next(int i, Unit& u) const {
        const long L = (long)i * G + c; if (L >= nwg) return false;
        int wgid = (int)L; { const int q = nwg / NXCD, r = nwg % NXCD, xcd = wgid % NXCD, off = wgid / NXCD; wgid = (xcd < r ? xcd * (q + 1) : r * (q + 1) + (xcd - r) * q) + off; }
        const int nig = WGM * nN, gid = wgid / nig, fm = gid * WGM, gsz = (nM - fm) < WGM ? (nM - fm) : WGM;
        u.pm = fm + ((wgid % nig) % gsz); u.pn = (wgid % nig) / gsz; u.kz = 0; u.nt = 0; return true;
    }
    __device__ __forceinline__ void a_ready(const Unit&) const {}
    __device__ __forceinline__ void done(const Unit&) const {}
};

__device__ __forceinline__ unsigned cvt_pk_bf16(float lo, float hi) { unsigned r; asm volatile("v_cvt_pk_bf16_f32 %0, %1, %2" : "=v"(r) : "v"(lo), "v"(hi)); return r; }
typedef float f32x2 __attribute__((ext_vector_type(2)));
__device__ __forceinline__ f32x2 gelu_pk(f32x2 v) {
    const f32x2 av = __builtin_elementwise_abs(v), d = av * 0.2316418882f + 1.0f;
    f32x2 t; t.x = __builtin_amdgcn_rcpf(d.x); t.y = __builtin_amdgcn_rcpf(d.y);
    f32x2 q = t * 0.5307027145f + (-0.7265760135f); q = q * t + 0.7107068705f; q = q * t + (-0.142248368f); q = q * t + 0.127414796f; q = q * t;
    const f32x2 s = (v * v) * (-0.72134752044f);
    f32x2 e; e.x = __builtin_amdgcn_exp2f(s.x); e.y = __builtin_amdgcn_exp2f(s.y);
    const f32x2 m = v * (q * e), r = v - m;
    f32x2 o; o.x = v.x < 0.f ? m.x : r.x; o.y = v.y < 0.f ? m.y : r.y; return o;
}

template <int ACT  > struct EpiBf16 {
    static constexpr bool PERM = true, AFTER_DRAIN = false; static_assert(ACT == 0 || ACT == 1, "EpiBf16: ACT is 0 (none) or 1 (gelu_pk)");
    bf16_t* O; int ldc; const float* bias; int split_cols; size_t split_stride; float scale0;
    __device__ __forceinline__ void operator()(const f32x4 (&acc)[2][2][4][2], const Unit& u, int wr, int wc, int fr, int fq) const {
        const int row0 = u.pm * BM + wr * 64 + fr; int colt = u.pn * BM; bf16_t* base = O;
        float sc = 1.f; if (split_cols) { const int t = colt / split_cols; base += (size_t)t * split_stride; colt -= t * split_cols; if (t == 0) sc = scale0; }
        const int col0 = colt + wc * 32 + 8 * fq, bcol0 = u.pn * BM + wc * 32 + 8 * fq;
        f32x4 bv[2][2];
#pragma unroll
        for (int bj = 0; bj < 2; ++bj)
#pragma unroll
            for (int n = 0; n < 2; ++n) bv[bj][n] = bias ? *(const f32x4*)(bias + bcol0 + bj * HALF + 4 * n) : (f32x4){0.f, 0.f, 0.f, 0.f};
#pragma unroll
        for (int ai = 0; ai < 2; ++ai)
#pragma unroll
            for (int m = 0; m < 4; ++m) { bf16_t* rowp = base + (size_t)(row0 + ai * HALF + m * 16) * ldc + col0;
#pragma unroll
                for (int bj = 0; bj < 2; ++bj) { f32x4 v0 = acc[ai][bj][m][0] + bv[bj][0], v1 = acc[ai][bj][m][1] + bv[bj][1];
                    if (ACT == 1) { f32x2 a = gelu_pk((f32x2){v0[0], v0[1]}), b = gelu_pk((f32x2){v0[2], v0[3]}), c = gelu_pk((f32x2){v1[0], v1[1]}), d = gelu_pk((f32x2){v1[2], v1[3]});
                        v0 = (f32x4){a.x, a.y, b.x, b.y}; v1 = (f32x4){c.x, c.y, d.x, d.y}; }
                    v0 = v0 * sc; v1 = v1 * sc; u32x4 w; w.x = cvt_pk_bf16(v0[0], v0[1]); w.y = cvt_pk_bf16(v0[2], v0[3]); w.z = cvt_pk_bf16(v1[0], v1[1]); w.w = cvt_pk_bf16(v1[2], v1[3]);
                    *(u32x4*)(rowp + bj * HALF) = w; } }
    }
};

struct PanelStats {
    unsigned* xbuf;
    unsigned* cnt;
    unsigned* tmo;
    int ntn; float eps;
    unsigned code;
    __device__ __forceinline__ bool run(const f32x4 (&v)[2][2][4][2], const Unit& u, int wr, int wc, int fr, int fq, PG8_LAS unsigned char* lds, int wid, int lane) const {
        typedef float f32x2v __attribute__((ext_vector_type(2)));
        PG8_LAS f32x2v* P = (PG8_LAS f32x2v*)lds;
        PG8_LAS f32x2v* S = (PG8_LAS f32x2v*)(lds + 8192);
        PG8_LAS unsigned* flag = (PG8_LAS unsigned*)(lds + 8192 + 2048);
#pragma unroll
        for (int ai = 0; ai < 2; ++ai)
#pragma unroll
            for (int m = 0; m < 4; ++m) {
                float s = 0.f;
#pragma unroll
                for (int bj = 0; bj < 2; ++bj)
#pragma unroll
                    for (int n = 0; n < 2; ++n) { const f32x4 x = v[ai][bj][m][n]; s += (x[0] + x[1]) + (x[2] + x[3]); }
                s += __shfl_xor(s, 16); s += __shfl_xor(s, 32);
                const float mw = s * (1.0f / 64.0f); float q = 0.f;
#pragma unroll
                for (int bj = 0; bj < 2; ++bj)
#pragma unroll
                    for (int n = 0; n < 2; ++n) { const f32x4 d = v[ai][bj][m][n] - mw; q += (d[0] * d[0] + d[1] * d[1]) + (d[2] * d[2] + d[3] * d[3]); }
                q += __shfl_xor(q, 16); q += __shfl_xor(q, 32);
                if (fq == 0) P[(ai * HALF + wr * 64 + m * 16 + fr) * 4 + wc] = (f32x2v){mw, q};
            }
        asm volatile("s_waitcnt lgkmcnt(0)" ::: "memory"); __builtin_amdgcn_s_barrier(); asm volatile("" ::: "memory");
#if defined(BROKEN_EXCHANGE_NO_WAIT)
#warning BROKEN CONTROL BUILD: the row-statistics exchange does not wait; results are wrong by design
        if (blockIdx.x >= 64) { const long long t0_ = clock64(); while (clock64() - t0_ < 60000) __builtin_amdgcn_s_sleep(8); }
#endif
        const int row = wid * 32 + (lane & 31);
        if (lane < 32) {
            const f32x2v a = P[row * 4 + 0], b = P[row * 4 + 1], c = P[row * 4 + 2], d = P[row * 4 + 3];
            const float mt = (a.x + b.x + c.x + d.x) * 0.25f;
            const float da = a.x - mt, db = b.x - mt, dc = c.x - mt, dd = d.x - mt;
            const float m2 = (a.y + b.y) + (c.y + d.y) + 64.0f * ((da * da + db * db) + (dc * dc + dd * dd));
            unsigned long long* slot = (unsigned long long*)xbuf + ((size_t)(u.pm * BM + row) * 4 + u.pn);
            __hip_atomic_store(slot, ((unsigned long long)__float_as_uint(m2) << 32) | __float_as_uint(mt), __ATOMIC_RELAXED, __HIP_MEMORY_SCOPE_AGENT);
        }
        asm volatile("s_waitcnt vmcnt(0)" ::: "memory");
        if (lane == 0) __hip_atomic_fetch_add(cnt + 64 * u.pm, 1u, __ATOMIC_RELAXED, __HIP_MEMORY_SCOPE_AGENT);
        if (wid == 0) {
            bool dead = false; const unsigned long long t0 = __builtin_amdgcn_s_memrealtime(); const unsigned want = 8u * (unsigned)ntn;
            for (;;) {
#if defined(BROKEN_EXCHANGE_NO_WAIT)
                break;
#endif
                if ((unsigned)__builtin_amdgcn_readfirstlane(__hip_atomic_load(cnt + 64 * u.pm, __ATOMIC_RELAXED, __HIP_MEMORY_SCOPE_AGENT)) >= want) break;
                if (__builtin_amdgcn_s_memrealtime() - t0 > 2000000ull) {
                    if (lane == 0) { unsigned expect = 0u; __hip_atomic_compare_exchange_strong(tmo + 1, &expect, code | (unsigned)(u.pm & 0xff), __ATOMIC_RELAXED, __ATOMIC_RELAXED, __HIP_MEMORY_SCOPE_AGENT);
                                     __hip_atomic_store(tmo, 1u, __ATOMIC_RELAXED, __HIP_MEMORY_SCOPE_AGENT); }
                    dead = true; break; }
                __builtin_amdgcn_s_sleep(2);
            }
            __builtin_amdgcn_fence(__ATOMIC_ACQUIRE, "agent");
            if (lane == 0) flag[0] = dead ? 1u : 0u;
        }
        asm volatile("s_waitcnt vmcnt(0) lgkmcnt(0)" ::: "memory"); __builtin_amdgcn_s_barrier(); asm volatile("" ::: "memory");
        const bool bad = flag[0] != 0u;
        if (lane < 32) {
            const unsigned long long* slot = (const unsigned long long*)xbuf + (size_t)(u.pm * BM + row) * 4; float mt[4], m2[4]; float ms = 0.f;
#pragma unroll
            for (int t = 0; t < 4; ++t) { if (t < ntn) { const unsigned long long w = __hip_atomic_load(slot + t, __ATOMIC_RELAXED, __HIP_MEMORY_SCOPE_AGENT); mt[t] = __uint_as_float((unsigned)w); m2[t] = __uint_as_float((unsigned)(w >> 32)); } else { mt[t] = 0.f; m2[t] = 0.f; } ms += mt[t]; }
            const float mean = ms / (float)ntn; float q = 0.f;
#pragma unroll
            for (int t = 0; t < 4; ++t) if (t < ntn) { const float dm = mt[t] - mean; q += m2[t] + 256.0f * dm * dm; }
            S[row] = (f32x2v){mean, 1.0f / sqrtf(q / (256.0f * (float)ntn) + eps)};
        }
        asm volatile("s_waitcnt lgkmcnt(0)" ::: "memory"); __builtin_amdgcn_s_barrier(); asm volatile("" ::: "memory");
        return bad;
    }
};
struct EpiLnRes {
    static constexpr bool PERM = false, AFTER_DRAIN = true;
    const float* base; float* out; int ldc; const float* bias; PanelStats st; unsigned poison;
    __device__ __forceinline__ void fused(f32x4 (&acc)[2][2][4][2], const Unit& u, int wr, int wc, int fr, int fq, PG8_LAS unsigned char* lds, int wid, int lane) const {
        typedef float f32x2v __attribute__((ext_vector_type(2)));
        const PG8_LAS f32x2v* S = (const PG8_LAS f32x2v*)(lds + 8192);
        const int col0 = u.pn * BM + wc * 32 + 4 * fq;
#pragma unroll
        for (int bj = 0; bj < 2; ++bj)
#pragma unroll
            for (int n = 0; n < 2; ++n) { const f32x4 bv = bias ? *(const f32x4*)(bias + col0 + bj * HALF + n * 16) : (f32x4){0.f, 0.f, 0.f, 0.f};
#pragma unroll
                for (int ai = 0; ai < 2; ++ai)
#pragma unroll
                    for (int m = 0; m < 4; ++m) acc[ai][bj][m][n] += bv; }
        f32x4 pre[4][2][2];
#pragma unroll
        for (int m = 0; m < 4; ++m) { const size_t off = (size_t)(u.pm * BM + wr * 64 + m * 16 + fr) * ldc + col0;
#pragma unroll
            for (int bj = 0; bj < 2; ++bj)
#pragma unroll
                for (int n = 0; n < 2; ++n) pre[m][bj][n] = *(const f32x4*)(base + off + bj * HALF + n * 16); }
        const bool bad = st.run(acc, u, wr, wc, fr, fq, lds, wid, lane) || poison != 0u;
        const float qnan = __builtin_nanf("");
#pragma unroll
        for (int ai = 0; ai < 2; ++ai)
#pragma unroll
            for (int m = 0; m < 4; ++m) { const int r = ai * HALF + wr * 64 + m * 16 + fr; const f32x2v sr = S[r]; const size_t off = (size_t)(u.pm * BM + r) * ldc + col0;
#pragma unroll
                for (int bj = 0; bj < 2; ++bj)
#pragma unroll
                    for (int n = 0; n < 2; ++n) { const f32x4 bs = ai == 0 ? pre[m][bj][n] : *(const f32x4*)(base + off + bj * HALF + n * 16); f32x4 o = bs + (acc[ai][bj][m][n] - sr.x) * sr.y;
                        if (bad) o = (f32x4){qnan, qnan, qnan, qnan}; *(f32x4*)(out + off + bj * HALF + n * 16) = o; }
                if (m & 1) asm volatile("" ::: "memory"); }
    }
};
struct EpiLnResLn {
    static constexpr bool PERM = false, AFTER_DRAIN = true;
    const float* base; float* out; bf16_t* xn; int ldc; const float* bias; PanelStats st1, st2; unsigned poison;
    __device__ __forceinline__ void fused(f32x4 (&acc)[2][2][4][2], const Unit& u, int wr, int wc, int fr, int fq, PG8_LAS unsigned char* lds, int wid, int lane) const {
        typedef float f32x2v __attribute__((ext_vector_type(2))); typedef unsigned u32x2v __attribute__((ext_vector_type(2)));
        const PG8_LAS f32x2v* S = (const PG8_LAS f32x2v*)(lds + 8192);
        const int col0 = u.pn * BM + wc * 32 + 4 * fq;
#pragma unroll
        for (int bj = 0; bj < 2; ++bj)
#pragma unroll
            for (int n = 0; n < 2; ++n) { const f32x4 bv = bias ? *(const f32x4*)(bias + col0 + bj * HALF + n * 16) : (f32x4){0.f, 0.f, 0.f, 0.f};
#pragma unroll
                for (int ai = 0; ai < 2; ++ai)
#pragma unroll
                    for (int m = 0; m < 4; ++m) acc[ai][bj][m][n] += bv; }
        bool bad = st1.run(acc, u, wr, wc, fr, fq, lds, wid, lane) || poison != 0u;
        const float qnan = __builtin_nanf("");
#pragma unroll
        for (int ai = 0; ai < 2; ++ai)
#pragma unroll
            for (int m = 0; m < 4; ++m) { const int r = ai * HALF + wr * 64 + m * 16 + fr; const f32x2v sr = S[r]; const size_t off = (size_t)(u.pm * BM + r) * ldc + col0;
#pragma unroll
                for (int bj = 0; bj < 2; ++bj)
#pragma unroll
                    for (int n = 0; n < 2; ++n) { const f32x4 bs = *(const f32x4*)(base + off + bj * HALF + n * 16); acc[ai][bj][m][n] = bs + (acc[ai][bj][m][n] - sr.x) * sr.y; }
                asm volatile("" : "+v"(acc[ai][0][m][0]), "+v"(acc[ai][0][m][1]), "+v"(acc[ai][1][m][0]), "+v"(acc[ai][1][m][1]));
                if (m & 1) asm volatile("" ::: "memory"); }
        const bool bad1 = bad;
        bad = st2.run(acc, u, wr, wc, fr, fq, lds, wid, lane) || bad;
#pragma unroll
        for (int ai = 0; ai < 2; ++ai)
#pragma unroll
            for (int m = 0; m < 4; ++m) { const int r = ai * HALF + wr * 64 + m * 16 + fr; const f32x2v sr = S[r]; const size_t off = (size_t)(u.pm * BM + r) * ldc + col0;
#pragma unroll
                for (int bj = 0; bj < 2; ++bj)
#pragma unroll
                    for (int n = 0; n < 2; ++n) { const f32x4 x1 = acc[ai][bj][m][n]; *(f32x4*)(out + off + bj * HALF + n * 16) = bad1 ? (f32x4){qnan, qnan, qnan, qnan} : x1;
                        const f32x4 o = (x1 - sr.x) * sr.y; u32x2v w; w.x = cvt_pk_bf16(o[0], o[1]); w.y = cvt_pk_bf16(o[2], o[3]);
                        if (bad) { w.x = 0x7fc07fc0u; w.y = 0x7fc07fc0u; } *(u32x2v*)(xn + off + bj * HALF + n * 16) = w; }
                asm volatile("" ::: "memory"); }
    }
};

template <class Epi, class Sched, bool ALIGN_EPI = false, bool SP2 = false>
__device__ __forceinline__ void gemm_phase(PG8_LAS unsigned char* lds, const Gemm g, const Sched& S, const Epi& E) {
    int tid_ = threadIdx.x; asm volatile("" : "+v"(tid_));
    const int tid = tid_, wid = __builtin_amdgcn_readfirstlane(tid >> 6), lane = tid & 63, wr = wid >> 2, wc = wid & 3, fr = lane & 15, fq = lane >> 4;
    const int K = g.ld, nt = g.K / BK; const size_t kzstep = 512;
    unsigned voffA[2], voffB[2];
#pragma unroll
    for (int i = 0; i < 2; ++i) { int R, C; stage_rc(tid * 16 + i * 8192, R, C); const int Rb = Epi::PERM ? ((R & ~31) + perm32(R & 31)) : R;
        voffA[i] = (unsigned)(R * K + C) * 2u; voffB[i] = (unsigned)(Rb * K + C) * 2u; }
    const size_t kstep = (size_t)(BK * 2);
    const size_t hstep = (size_t)HALF * K * 2;
    const size_t tstep = 2 * hstep;
    const unsigned ldsw = (unsigned)wid * 1024u;
    const int aoff = lds_byte(wr * 64 + fr, fq * 8), boff = lds_byte(wc * 32 + fr, fq * 8);
#define PG8_SA(b, h) (((b) * 2 + (h)) * HTB)
#define PG8_SB(b, h) ((4 + (b) * 2 + (h)) * HTB)
#define PG8_STAGE(bufoff, gbase, voff) do { _Pragma("unroll") for (int _i = 0; _i < 2; ++_i) \
        __builtin_amdgcn_global_load_lds((const unsigned*)((const char*)(gbase) + (voff)[_i]), (PG8_LAS unsigned*)(lds + (bufoff) + ldsw + _i * 8192), 16, 0, 0); } while (0)
#define PG8_LDA(dst, b, h) do { _Pragma("unroll") for (int m = 0; m < 4; ++m) _Pragma("unroll") for (int k = 0; k < 2; ++k) dst[m][k] = *(const PG8_LAS bf16x8*)(lds + PG8_SA(b, h) + aoff + m * 2048 + k * 1024); } while (0)
#define PG8_LDB(dst, b, h) do { _Pragma("unroll") for (int n = 0; n < 2; ++n) _Pragma("unroll") for (int k = 0; k < 2; ++k) dst[n][k] = *(const PG8_LAS bf16x8*)(lds + PG8_SB(b, h) + boff + n * 2048 + k * 1024); } while (0)
#define PG8_MMA(ai, bj, At, Bt) do { __builtin_amdgcn_s_setprio(1); _Pragma("unroll") for (int m = 0; m < 4; ++m) _Pragma("unroll") for (int n = 0; n < 2; ++n) _Pragma("unroll") for (int k = 0; k < 2; ++k) \
        acc[ai][bj][m][n] = __builtin_amdgcn_mfma_f32_16x16x32_bf16(Bt[n][k], At[m][k], acc[ai][bj][m][n], 0, 0, 0); __builtin_amdgcn_s_setprio(0); } while (0)
#define PG8_WAIT_V(n) asm volatile("s_waitcnt vmcnt(" #n ")" ::: "memory")
#define PG8_WAIT_L(n) asm volatile("s_waitcnt lgkmcnt(" #n ")" ::: "memory")
#define PG8_BAR __builtin_amdgcn_s_barrier()
#define PG8_SCHED __builtin_amdgcn_sched_barrier(0)
    Unit cur, nxt; int ui = 0;
    if (!S.next(0, cur)) return;
    f32x4 acc[2][2][4][2];
#pragma unroll
    for (int a = 0; a < 2; ++a)
#pragma unroll
        for (int b = 0; b < 2; ++b)
#pragma unroll
            for (int m = 0; m < 4; ++m)
#pragma unroll
                for (int n = 0; n < 2; ++n) acc[a][b][m][n] = (f32x4){0.f, 0.f, 0.f, 0.f};
    bf16x8 At[4][2], B0[2][2], B1[2][2];
    const char* cA = (const char*)g.A + (size_t)cur.pm * tstep + (size_t)cur.kz * kzstep; const char* cB = (const char*)g.Bt + (size_t)cur.pn * tstep + (size_t)cur.kz * kzstep;
    S.a_ready(cur);
    if constexpr (SP2) {
        PG8_STAGE(PG8_SB(0, 0), cB, voffB); PG8_STAGE(PG8_SB(0, 1), cB + hstep, voffB); PG8_STAGE(PG8_SA(0, 0), cA, voffA); PG8_STAGE(PG8_SA(0, 1), cA + hstep, voffA);
        if (wr == 1) PG8_BAR;
        PG8_WAIT_V(2); PG8_BAR;
        PG8_STAGE(PG8_SB(1, 0), cB + kstep, voffB); PG8_STAGE(PG8_SA(1, 0), cA + kstep, voffA); PG8_STAGE(PG8_SB(1, 1), cB + hstep + kstep, voffB);
        PG8_WAIT_V(6); PG8_BAR;
    } else {
        PG8_STAGE(PG8_SB(0, 0), cB, voffB); PG8_STAGE(PG8_SA(0, 0), cA, voffA); PG8_STAGE(PG8_SB(0, 1), cB + hstep, voffB); PG8_STAGE(PG8_SA(0, 1), cA + hstep, voffA);
        if (wr == 1) PG8_BAR;
        PG8_WAIT_V(4); PG8_BAR;
        PG8_STAGE(PG8_SB(1, 0), cB + kstep, voffB); PG8_STAGE(PG8_SA(1, 0), cA + kstep, voffA); PG8_STAGE(PG8_SB(1, 1), cB + hstep + kstep, voffB);
        PG8_WAIT_V(6); PG8_BAR;
    }
    for (;;) {
        const bool has_next = S.next(ui + 1, nxt);
        const char* nA = has_next ? (const char*)g.A + (size_t)nxt.pm * tstep + (size_t)nxt.kz * kzstep : cA; const char* nB = has_next ? (const char*)g.Bt + (size_t)nxt.pn * tstep + (size_t)nxt.kz * kzstep : cB;
        const int ntu = cur.nt ? cur.nt : nt;
        for (int t = 0; t < ntu; t += 2) {
            const bool last = (t == ntu - 2);
            const char* a1 = cA + (size_t)(t + 1) * kstep;
            const char* a2 = last ? nA : cA + (size_t)(t + 2) * kstep; const char* b2 = last ? nB : cB + (size_t)(t + 2) * kstep;
            const char* a3 = a2 + kstep; const char* b3 = b2 + kstep;
            if (last && has_next) S.a_ready(nxt);
            if constexpr (SP2) {
            PG8_LDB(B0, 0, 0); PG8_LDB(B1, 0, 1); PG8_SCHED; PG8_LDA(At, 0, 0); PG8_STAGE(PG8_SA(1, 1), a1 + hstep, voffA);
            PG8_WAIT_V(8); PG8_WAIT_L(0); PG8_BAR; PG8_MMA(0, 0, At, B0); PG8_MMA(0, 1, At, B1); PG8_BAR; PG8_SCHED;
            PG8_LDA(At, 0, 1); PG8_STAGE(PG8_SB(0, 0), b2, voffB); PG8_STAGE(PG8_SB(0, 1), b2 + hstep, voffB); PG8_STAGE(PG8_SA(0, 0), a2, voffA);
            PG8_WAIT_V(8); PG8_WAIT_L(0); PG8_BAR; PG8_MMA(1, 0, At, B0); PG8_MMA(1, 1, At, B1); PG8_BAR; PG8_SCHED;
            PG8_LDB(B0, 1, 0); PG8_LDB(B1, 1, 1); PG8_SCHED; PG8_LDA(At, 1, 0); PG8_STAGE(PG8_SA(0, 1), a2 + hstep, voffA);
            PG8_WAIT_V(8); PG8_WAIT_L(0); PG8_BAR; PG8_MMA(0, 0, At, B0); PG8_MMA(0, 1, At, B1); PG8_BAR; PG8_SCHED;
            PG8_LDA(At, 1, 1); PG8_STAGE(PG8_SB(1, 0), b3, voffB); PG8_STAGE(PG8_SB(1, 1), b3 + hstep, voffB); PG8_STAGE(PG8_SA(1, 0), a3, voffA);
            PG8_WAIT_V(8); PG8_WAIT_L(0); PG8_BAR; PG8_MMA(1, 0, At, B0); PG8_MMA(1, 1, At, B1); PG8_BAR; PG8_SCHED;
            } else {
            PG8_LDB(B0, 0, 0); PG8_SCHED; PG8_LDA(At, 0, 0); PG8_STAGE(PG8_SA(1, 1), a1 + hstep, voffA);
            PG8_WAIT_L(8); PG8_BAR; PG8_WAIT_L(0); PG8_MMA(0, 0, At, B0); PG8_BAR; PG8_SCHED;
            PG8_LDB(B1, 0, 1); PG8_STAGE(PG8_SB(0, 0), b2, voffB);
            PG8_BAR; PG8_WAIT_L(0); PG8_MMA(0, 1, At, B1); PG8_BAR;
            PG8_LDA(At, 0, 1); PG8_STAGE(PG8_SA(0, 0), a2, voffA);
            PG8_BAR; PG8_WAIT_L(0); PG8_MMA(1, 0, At, B0); PG8_BAR; PG8_SCHED;
            PG8_STAGE(PG8_SB(0, 1), b2 + hstep, voffB);
            PG8_WAIT_V(6); PG8_BAR; PG8_MMA(1, 1, At, B1); PG8_BAR;
            PG8_LDB(B0, 1, 0); PG8_SCHED; PG8_LDA(At, 1, 0); PG8_STAGE(PG8_SA(0, 1), a2 + hstep, voffA);
            PG8_WAIT_L(8); PG8_BAR; PG8_WAIT_L(0); PG8_MMA(0, 0, At, B0); PG8_BAR; PG8_SCHED;
            PG8_LDB(B1, 1, 1); PG8_STAGE(PG8_SB(1, 0), b3, voffB);
            PG8_BAR; PG8_WAIT_L(0); PG8_MMA(0, 1, At, B1); PG8_BAR;
            PG8_LDA(At, 1, 1); PG8_STAGE(PG8_SA(1, 0), a3, voffA);
            PG8_BAR; PG8_WAIT_L(0); PG8_MMA(1, 0, At, B0); PG8_BAR; PG8_SCHED;
            PG8_STAGE(PG8_SB(1, 1), b3 + hstep, voffB);
            PG8_WAIT_V(6); PG8_BAR; PG8_MMA(1, 1, At, B1); PG8_BAR;
            }
        }
        if constexpr (ALIGN_EPI) { if (wr == 0) PG8_BAR; }
        if constexpr (!Epi::AFTER_DRAIN) { E(acc, cur, wr, wc, fr, fq); S.done(cur); }
        if (!has_next) break;
#pragma unroll
        for (int a = 0; a < 2; ++a)
#pragma unroll
            for (int b = 0; b < 2; ++b)
#pragma unroll
                for (int m = 0; m < 4; ++m)
#pragma unroll
                    for (int n = 0; n < 2; ++n) acc[a][b][m][n] = (f32x4){0.f, 0.f, 0.f, 0.f};
        cur = nxt; cA = nA; cB = nB; ++ui;
        if constexpr (ALIGN_EPI) { if (wr == 1) PG8_BAR; }
    }
    PG8_WAIT_V(0);
    if constexpr (!ALIGN_EPI) { if (wr == 0) PG8_BAR; }
    PG8_BAR;
    if constexpr (Epi::AFTER_DRAIN) { E.fused(acc, cur, wr, wc, fr, fq, lds, wid, lane); S.done(cur); }
#undef PG8_SA
#undef PG8_SB
#undef PG8_STAGE
#undef PG8_LDA
#undef PG8_LDB
#undef PG8_MMA
#undef PG8_WAIT_V
#undef PG8_WAIT_L
#undef PG8_BAR
#undef PG8_SCHED
}
}


#ifndef PG8_SP2
#define PG8_SP2 true
#endif
#ifndef PG8_ALIGN
#define PG8_ALIGN true
#endif

#define GAS __attribute__((address_space(1)))
#define LAS __attribute__((address_space(3)))

namespace mk {
using pg8::bf16_t; using pg8::bf16x8; using pg8::f32x4; using pg8::u32x4; using pg8::Unit;
typedef float f32x2 __attribute__((ext_vector_type(2)));
typedef unsigned u32x2 __attribute__((ext_vector_type(2)));
typedef __bf16 bf16x2_t __attribute__((ext_vector_type(2)));

constexpr int NWAVES = 8, NTHREADS = 512;
constexpr int D = 1024, BATCH = 2, SEQ = 8192, CTXL = 256, DEPTH = 4, DFF = 2816, DI = 2048, NH = 4, DH = 512, EH = 3072;
constexpr int ML = BATCH * SEQ, MC = BATCH * CTXL, R = ML + MC;
constexpr int NPOS = CTXL + SEQ, NCHUNK = NPOS / 64;
constexpr float EPS = 1e-6f;

constexpr size_t MiB = 1u << 20;
constexpr size_t WS_CTL = 0, CTL_ZERO_BYTES = 1 * MiB;
constexpr size_t WS_MOD = 1 * MiB;
constexpr size_t WS_CTXS = 2 * MiB;
constexpr size_t WS_GATES = 4 * MiB;
constexpr size_t WS_WCM = 5 * MiB + 256 * 1024;
constexpr size_t WS_GB = 6 * MiB, WS_GM = WS_GB + 640 * 1024, WS_GI = WS_GM + 640 * 1024;
constexpr size_t WS_WFI = 8 * MiB, WS_WFO = 96 * MiB, WS_WAI = 140 * MiB, WS_WAO = 156 * MiB, WS_WBI = 164 * MiB, WS_WBO = 188 * MiB;
constexpr size_t WS_XN = 200 * MiB, WS_Y = 233 * MiB, WS_NUMB = 200 * MiB;
constexpr size_t WS_T0 = 266 * MiB;
constexpr size_t WS_H = WS_T0;
constexpr size_t WS_U = WS_T0, WS_V = 365 * MiB, WS_VST = 464 * MiB;
constexpr size_t WS_XM = WS_T0, WS_NUMF = WS_T0, WS_Z = 332 * MiB, WS_XC = 398 * MiB, WS_Q = 464 * MiB, WS_G = WS_Q, WS_K = 530 * MiB, WS_VV = 596 * MiB;
constexpr size_t WS_YCP = 400 * MiB;
constexpr size_t WS_SRAW = 662 * MiB, WS_PD = 671 * MiB, WS_SDT = 680 * MiB, WS_TAB = 698 * MiB, WS_END = 701 * MiB;
constexpr int CW_BAR = 4096;

constexpr int RING_BYTES = 139264, LDSCTL_OFF = RING_BYTES, MISC_OFF = LDSCTL_OFF + 320, LDS_BYTES = 155648;

__device__ __forceinline__ unsigned cvtpk(float lo, float hi) { f32x2 v = {lo, hi}; bf16x2_t b = __builtin_convertvector(v, bf16x2_t); return __builtin_bit_cast(unsigned, b); }
__device__ __forceinline__ float bflo(unsigned u) { return __builtin_bit_cast(float, u << 16); }
__device__ __forceinline__ float bfhi(unsigned u) { return __builtin_bit_cast(float, u & 0xffff0000u); }
__device__ __forceinline__ float bf2f(bf16_t u) { return __builtin_bit_cast(float, (unsigned)u << 16); }
__device__ __forceinline__ bf16_t f2bf(float f) { return (bf16_t)(cvtpk(f, 0.f) & 0xffffu); }
__device__ __forceinline__ float wave_sum(float v) {
#pragma unroll
    for (int o = 1; o < 64; o <<= 1) v += __shfl_xor(v, o);
    return v;
}
__device__ __forceinline__ float silu_f(float v) { return v * __builtin_amdgcn_rcpf(1.0f + __expf(-v)); }
__device__ __forceinline__ f32x4 mfma16(bf16x8 a, bf16x8 b, f32x4 c) { return __builtin_amdgcn_mfma_f32_16x16x32_bf16(a, b, c, 0, 0, 0); }
#define LDS_WAIT() asm volatile("s_waitcnt lgkmcnt(0)" ::: "memory")
#define VM_WAIT() asm volatile("s_waitcnt vmcnt(0)" ::: "memory")

#define XB_TMO      128
#define XB_XCNT(j)  (256  + 64 * (j))
#define XB_XSUB(j)  (1280 + 64 * (j))
#define XB_XGEN(j)  (2304 + 64 * (j))
#define XB_TOP      3328
#define XB_TOPGEN   3392
#define XCD_BAR_WORDS 3456
#define XB_SPIN_CAP (1u << 18)
__device__ __forceinline__ unsigned xb_ld(unsigned* p)              { return __hip_atomic_load(p, __ATOMIC_RELAXED, __HIP_MEMORY_SCOPE_AGENT); }
__device__ __forceinline__ unsigned xb_add(unsigned* p, unsigned v) { return __hip_atomic_fetch_add(p, v, __ATOMIC_RELAXED, __HIP_MEMORY_SCOPE_AGENT); }
__device__ __forceinline__ unsigned xb_xcc_id() { return (unsigned)__builtin_amdgcn_s_getreg((3 << 11) | 20) & 0xFu; }
#define XB_SPIN(cond, bar) do { unsigned _sp = 0; while (cond) { __builtin_amdgcn_s_sleep(1); \
    if ((++_sp & 255u) == 0u) { if (xb_ld(&(bar)[XB_TMO])) break; if (_sp > XB_SPIN_CAP) { atomicAdd(&(bar)[XB_TMO], 1u); break; } } } } while (0)
struct XcdBarrier { unsigned* bar; unsigned x; volatile LAS unsigned* st; };
__device__ __forceinline__ XcdBarrier xcd_barrier_post(unsigned* bar, volatile LAS unsigned* st) {
    XcdBarrier b; b.bar = bar; b.x = xb_xcc_id(); b.st = st;
    if (threadIdx.x == 0) (void)xb_add(&bar[XB_XCNT(b.x)], 1u);
    return b;
}
__device__ __forceinline__ void xcd_barrier_complete(unsigned* bar, unsigned x, unsigned& nloc, unsigned& nx) {
    const unsigned G = gridDim.x * gridDim.y * gridDim.z;
    unsigned sum, cnt, mine, sp = 0u;
    for (;;) {
        sum = 0u; cnt = 0u; mine = 0u;
#pragma unroll
        for (unsigned j = 0; j < 16; ++j) { const unsigned c = xb_ld(&bar[XB_XCNT(j)]); sum += c; cnt += (c > 0u) ? 1u : 0u; mine = (j == x) ? c : mine; }
        if (sum == G) break;
        __builtin_amdgcn_s_sleep(1);
        if ((++sp & 255u) == 0u) { if (xb_ld(&bar[XB_TMO])) break; if (sp > XB_SPIN_CAP) { atomicAdd(&bar[XB_TMO], 1u); break; } }
    }
    nloc = mine > 0u ? mine : 1u; nx = cnt > 0u ? cnt : 1u;
}
__device__ __forceinline__ void xcd_barrier(const XcdBarrier& b) {
    asm volatile("s_waitcnt vmcnt(0)" ::: "memory");
    __syncthreads();
    if (threadIdx.x == 0) {
        unsigned* bar = b.bar;
        __builtin_amdgcn_s_waitcnt(0);
        unsigned nloc = b.st[0], nx = b.st[1];
        if (nloc == 0u) { xcd_barrier_complete(bar, b.x, nloc, nx); b.st[0] = nloc; b.st[1] = nx; }
        const unsigned old = xb_add(&bar[XB_XSUB(b.x)], 1u);
        const unsigned gen = old / nloc;
        if (old + 1u == (gen + 1u) * nloc) {
            __builtin_amdgcn_fence(__ATOMIC_RELEASE, "agent");
            asm volatile("s_waitcnt vmcnt(0)" ::: "memory");
            const unsigned og = xb_add(&bar[XB_TOP], 1u);
            const unsigned tg = og / nx;
            if (og + 1u == (tg + 1u) * nx) xb_add(&bar[XB_TOPGEN], 1u);
            else XB_SPIN(xb_ld(&bar[XB_TOPGEN]) == tg, bar);
            __builtin_amdgcn_fence(__ATOMIC_ACQUIRE, "agent");
            xb_add(&bar[XB_XGEN(b.x)], 1u);
            asm volatile("s_waitcnt vmcnt(0)" ::: "memory");
        } else {
            XB_SPIN(xb_ld(&bar[XB_XGEN(b.x)]) == gen, bar);
            __builtin_amdgcn_fence(__ATOMIC_ACQUIRE, "agent");
            asm volatile("s_waitcnt vmcnt(0)" ::: "memory");
        }
    }
    __syncthreads();
}

struct EpiSwiGLU {
    static constexpr bool PERM = true, AFTER_DRAIN = false;
    bf16_t* O; int ldc;
    __device__ __forceinline__ void operator()(const f32x4 (&acc)[2][2][4][2], const Unit& u, int wr, int wc, int fr, int fq) const {
        const int row0 = u.pm * 256 + wr * 64 + fr, col0 = u.pn * 128 + wc * 32 + 8 * fq;
#pragma unroll
        for (int ai = 0; ai < 2; ++ai)
#pragma unroll
            for (int m = 0; m < 4; ++m) {
                bf16_t* rowp = O + (size_t)(row0 + ai * 128 + m * 16) * ldc + col0;
                const f32x4 g0 = acc[ai][0][m][0], g1 = acc[ai][0][m][1], u0 = acc[ai][1][m][0], u1 = acc[ai][1][m][1];
                u32x4 w;
                w.x = cvtpk(silu_f(g0[0]) * u0[0], silu_f(g0[1]) * u0[1]); w.y = cvtpk(silu_f(g0[2]) * u0[2], silu_f(g0[3]) * u0[3]);
                w.z = cvtpk(silu_f(g1[0]) * u1[0], silu_f(g1[1]) * u1[1]); w.w = cvtpk(silu_f(g1[2]) * u1[2], silu_f(g1[3]) * u1[3]);
                *(u32x4*)rowp = w;
            }
    }
};
struct EpiGeluUV {
    static constexpr bool PERM = true, AFTER_DRAIN = false;
    bf16_t* U; bf16_t* V; const float* bias; float* vst;
    __device__ __forceinline__ void operator()(const f32x4 (&acc)[2][2][4][2], const Unit& u, int wr, int wc, int fr, int fq) const {
        const int row0 = u.pm * 256 + wr * 64 + fr;
        const int t = (u.pn >= 12) ? 1 : 0;
        bf16_t* base = t ? V : U;
        const int col0 = (u.pn - 12 * t) * 256 + wc * 32 + 8 * fq, bcol0 = u.pn * 256 + wc * 32 + 8 * fq;
        f32x4 bv[2][2];
#pragma unroll
        for (int bj = 0; bj < 2; ++bj)
#pragma unroll
            for (int n = 0; n < 2; ++n) bv[bj][n] = *(const f32x4*)(bias + bcol0 + bj * 128 + 4 * n);
#pragma unroll
        for (int ai = 0; ai < 2; ++ai)
#pragma unroll
            for (int m = 0; m < 4; ++m) {
                const int row = row0 + ai * 128 + m * 16;
                bf16_t* rowp = base + (size_t)row * EH + col0;
                float s = 0.f, q = 0.f;
#pragma unroll
                for (int bj = 0; bj < 2; ++bj) {
                    f32x4 v0 = acc[ai][bj][m][0] + bv[bj][0], v1 = acc[ai][bj][m][1] + bv[bj][1];
                    pg8::f32x2 a = pg8::gelu_pk((pg8::f32x2){v0[0], v0[1]}), b = pg8::gelu_pk((pg8::f32x2){v0[2], v0[3]}), c = pg8::gelu_pk((pg8::f32x2){v1[0], v1[1]}), d = pg8::gelu_pk((pg8::f32x2){v1[2], v1[3]});
                    u32x4 w; w.x = cvtpk(a.x, a.y); w.y = cvtpk(b.x, b.y); w.z = cvtpk(c.x, c.y); w.w = cvtpk(d.x, d.y);
                    *(u32x4*)(rowp + bj * 128) = w;
                    s += (a.x + a.y) + (b.x + b.y) + (c.x + c.y) + (d.x + d.y);
                    q += (a.x * a.x + a.y * a.y) + (b.x * b.x + b.y * b.y) + (c.x * c.x + c.y * c.y) + (d.x * d.x + d.y * d.y);
                }
                if (t) {
                    s += __shfl_xor(s, 16); s += __shfl_xor(s, 32); q += __shfl_xor(q, 16); q += __shfl_xor(q, 32);
                    if (fq == 0) *(f32x2*)(vst + ((size_t)row * 48 + (u.pn - 12) * 4 + wc) * 2) = (f32x2){s, q};
                }
            }
    }
};

struct OutOrder {
    pg8::StaticOrder so; int nks, G, c;
    __host__ __device__ void init(int K, int G_, int c_) { so.init(ML, D, G_, c_); nks = K / 256; G = G_; c = c_; }
    __device__ bool next(int i, Unit& u) const {
        if (i == 0) return so.next(0, u);
        const int L = (i - 1) * G + ((c + 128) % G); if (L >= 8 * nks) return false;
        u.kz = L >> 3; u.pm = 64 + ((L >> 2) & 1); u.pn = L & 3; u.nt = 4; return true; }
    __device__ __forceinline__ void a_ready(const Unit&) const {}
    __device__ __forceinline__ void done(const Unit&) const {}
};
struct EpiOut {
    static constexpr bool PERM = true, AFTER_DRAIN = false;
    bf16_t* Yo; float* P; const float* bias;
    __device__ __forceinline__ void operator()(const f32x4 (&acc)[2][2][4][2], const Unit& u, int wr, int wc, int fr, int fq) const {
        const int col0 = u.pn * 256 + wc * 32 + 8 * fq;
        const bool addb = (bias != nullptr) && (u.kz == 0);
        f32x4 bv[2][2];
#pragma unroll
        for (int bj = 0; bj < 2; ++bj)
#pragma unroll
            for (int n = 0; n < 2; ++n) bv[bj][n] = addb ? *(const f32x4*)(bias + col0 + bj * 128 + 4 * n) : (f32x4){0.f, 0.f, 0.f, 0.f};
        const bool lat = u.pm < 64;
        const int row0 = (lat ? u.pm : u.pm - 64) * 256 + wr * 64 + fr;
        unsigned char* base = lat ? (unsigned char*)Yo : (unsigned char*)(P + (size_t)u.kz * MC * D);
        const int sh = lat ? 1 : 2;
#pragma unroll
        for (int ai = 0; ai < 2; ++ai)
#pragma unroll
            for (int m = 0; m < 4; ++m) { unsigned char* rowp = base + (((size_t)(row0 + ai * 128 + m * 16) * D + col0) << sh);
#pragma unroll
                for (int bj = 0; bj < 2; ++bj) { const f32x4 v0 = acc[ai][bj][m][0] + bv[bj][0], v1 = acc[ai][bj][m][1] + bv[bj][1];
                    if (lat) { u32x4 w; w.x = cvtpk(v0[0], v0[1]); w.y = cvtpk(v0[2], v0[3]); w.z = cvtpk(v1[0], v1[1]); w.w = cvtpk(v1[2], v1[3]); *(u32x4*)(rowp + bj * 256) = w; }
                    else { *(f32x4*)(rowp + bj * 512) = v0; *(f32x4*)(rowp + bj * 512 + 16) = v1; } }
                asm volatile("" ::: "memory"); }
    }
};

__device__ __forceinline__ void p0_transpose_item(const float* W, int K, int N, bf16_t* WT, int mode, LAS float* scr, int item, int lane, int pmode) {
    const int nblk = N / 64, kb = item / nblk, nb = item % nblk, k0 = 64 * kb, n0 = 64 * nb;
    int orow0 = n0;
    if (mode) { const int hh = (n0 < DFF) ? n0 : n0 - DFF; orow0 = (hh >> 7) * 256 + (hh & 127) + ((n0 < DFF) ? 0 : 128); }
    const int kr = lane >> 4, nc = 4 * (lane & 15);
    const float* wp = W + (size_t)(k0 + kr) * N + n0 + nc;
    f32x4 v[16];
#pragma unroll
    for (int i = 0; i < 16; ++i) v[i] = (pmode & 2) ? (f32x4){1.f, 2.f, 3.f, 4.f} : __builtin_nontemporal_load((const f32x4*)(wp + (size_t)(4 * i) * N));
#pragma unroll
    for (int i = 0; i < 16; ++i) { LAS float* d = scr + (4 * i + kr) * 65 + nc; d[0] = v[i].x; d[1] = v[i].y; d[2] = v[i].z; d[3] = v[i].w; }
    LDS_WAIT(); asm volatile("" ::: "memory");
    const int kc = lane & 7;
#pragma unroll
    for (int j = 0; j < 8; ++j) { const int n = (lane >> 3) + 8 * j; const LAS float* sp = scr + (8 * kc) * 65 + n;
        u32x4 o; o.x = cvtpk(sp[0 * 65], sp[1 * 65]); o.y = cvtpk(sp[2 * 65], sp[3 * 65]); o.z = cvtpk(sp[4 * 65], sp[5 * 65]); o.w = cvtpk(sp[6 * 65], sp[7 * 65]);
        if (!(pmode & 1)) *(u32x4*)(WT + (size_t)(orow0 + n) * K + k0 + 8 * kc) = o; }
    LDS_WAIT(); asm volatile("" ::: "memory");
}
__device__ __forceinline__ void adaln_unit(const float* c, const float* cctx, const float* w_ada, const float* b_ada, float* MOD, LAS unsigned char* lds, int unit, int tid, int wave, int lane) {
    asm volatile("" : "+v"(tid), "+v"(lane));
    LAS float* sc = (LAS float*)lds;
    LAS float* red = sc + 3 * 1024;
    const int layer = unit / 36, cb = unit % 36;
    for (int i = tid; i < 3072; i += NTHREADS) { const int b = i >> 10, k = i & 1023; const float v = (b < 2) ? c[b * 1024 + k] : cctx[k]; sc[i] = v / (1.0f + __expf(-v)); }
    __syncthreads();
    const float* wp = w_ada + ((size_t)layer * 1024 + wave * 128) * 9216 + cb * 256 + lane * 4;
    f32x4 a0 = {0.f, 0.f, 0.f, 0.f}, a1 = a0, a2 = a0;
#pragma unroll 16
    for (int kk = 0; kk < 128; ++kk) { const f32x4 w = __builtin_nontemporal_load((const f32x4*)(wp + (size_t)kk * 9216)); const int k = wave * 128 + kk;
        a0 += w * sc[k]; a1 += w * sc[1024 + k]; a2 += w * sc[2048 + k]; }
    *(LAS f32x4*)(red + (wave * 3 + 0) * 256 + lane * 4) = a0; *(LAS f32x4*)(red + (wave * 3 + 1) * 256 + lane * 4) = a1; *(LAS f32x4*)(red + (wave * 3 + 2) * 256 + lane * 4) = a2;
    __syncthreads();
    for (int o = tid; o < 768; o += NTHREADS) { const int b = o >> 8, col = o & 255; float s = b_ada[layer * 9216 + cb * 256 + col];
#pragma unroll
        for (int w = 0; w < 8; ++w) s += red[(w * 3 + b) * 256 + col];
        MOD[(size_t)(layer * 3 + b) * 9216 + cb * 256 + col] = s; }
    __syncthreads();
}

struct ThinP { int first, has_y, lp, gate_i, gpost_i; float wgt; int has_next, ln, gpre_i, shift_i, scale_i; };
__device__ __forceinline__ void thin_load(const ThinP& p, int r, const float* xin, const float* ctxin, const float* X, const float* CTXS, const bf16_t* Y, const float* YCP, int nks, int lane, f32x4 (&x)[4], f32x4 (&y)[4]) {
    const float* xr = (r < ML) ? X + (size_t)r * D : CTXS + (size_t)(r - ML) * D;
    const float* src = p.first ? ((r < ML) ? xin + (size_t)r * D : ctxin + (size_t)(r - ML) * D) : xr;
#pragma unroll
    for (int j = 0; j < 4; ++j) x[j] = *(const f32x4*)(src + 4 * lane + 256 * j);
    if (p.has_y) {
        if (r < ML) {
#pragma unroll
            for (int j = 0; j < 4; ++j) { const u32x2 w = *(const u32x2*)(Y + (size_t)r * D + 4 * lane + 256 * j); y[j] = (f32x4){bflo(w.x), bfhi(w.x), bflo(w.y), bfhi(w.y)}; }
        } else {
#pragma unroll 1
            for (int j = 0; j < 4; ++j) { f32x4 pv[12];
#pragma unroll
                for (int kz = 0; kz < 12; ++kz) pv[kz] = (kz < nks) ? *(const f32x4*)(YCP + ((size_t)kz * MC + (r - ML)) * D + 4 * lane + 256 * j) : (f32x4){0.f, 0.f, 0.f, 0.f};
                f32x4 a = pv[0];
#pragma unroll
                for (int kz = 1; kz < 12; ++kz) a += pv[kz];
                if (j == 0) y[0] = a; else if (j == 1) y[1] = a; else if (j == 2) y[2] = a; else y[3] = a; }
        }
    }
}
struct ThinVec { f32x4 cpost[4], cpre[4], csh[4]; };
__device__ __forceinline__ void thin_vecs(const ThinP& p, int bsel, const float* MOD, const float* normg, int lane, ThinVec& v) {
    if (p.has_y) { const float* gate = MOD + (size_t)(p.lp * 3 + bsel) * 9216 + p.gate_i * D; const float* gp = normg + (size_t)(p.lp * 6 + p.gpost_i) * D;
#pragma unroll
        for (int j = 0; j < 4; ++j) v.cpost[j] = *(const f32x4*)(gate + 4 * lane + 256 * j) * *(const f32x4*)(gp + 4 * lane + 256 * j) * p.wgt; }
    if (p.has_next) { const float* mb = MOD + (size_t)(p.ln * 3 + bsel) * 9216; const float* gp = normg + (size_t)(p.ln * 6 + p.gpre_i) * D;
#pragma unroll
        for (int j = 0; j < 4; ++j) { const int cc = 4 * lane + 256 * j; v.cpre[j] = *(const f32x4*)(gp + cc) * (*(const f32x4*)(mb + p.scale_i * D + cc) + 1.0f); v.csh[j] = *(const f32x4*)(mb + p.shift_i * D + cc); } }
}
__device__ __forceinline__ void thin_row(const ThinP& p, int r, float* X, float* CTXS, bf16_t* XN, const ThinVec& tv, int lane, f32x4 (&x)[4], const f32x4 (&y)[4]) {
    float* xr = (r < ML) ? X + (size_t)r * D : CTXS + (size_t)(r - ML) * D;
    if (p.has_y) {
        float ss = 0.f;
#pragma unroll
        for (int j = 0; j < 4; ++j) ss += (y[j].x * y[j].x + y[j].y * y[j].y) + (y[j].z * y[j].z + y[j].w * y[j].w);
        const float rinv = 1.0f / sqrtf(wave_sum(ss) * (1.0f / D) + EPS);
#pragma unroll
        for (int j = 0; j < 4; ++j) x[j] += tv.cpost[j] * y[j] * rinv;
    }
    if (p.has_y) {
#pragma unroll
        for (int j = 0; j < 4; ++j) *(f32x4*)(xr + 4 * lane + 256 * j) = x[j];
    }
    if (p.has_next) {
        float ss = 0.f;
#pragma unroll
        for (int j = 0; j < 4; ++j) ss += (x[j].x * x[j].x + x[j].y * x[j].y) + (x[j].z * x[j].z + x[j].w * x[j].w);
        const float rinv = 1.0f / sqrtf(wave_sum(ss) * (1.0f / D) + EPS);
#pragma unroll
        for (int j = 0; j < 4; ++j) { const int cc = 4 * lane + 256 * j; const f32x4 o = x[j] * rinv * tv.cpre[j] + tv.csh[j]; u32x2 w; w.x = cvtpk(o.x, o.y); w.y = cvtpk(o.z, o.w);
            *(u32x2*)(XN + (size_t)r * D + cc) = w; }
    }
}
__device__ __forceinline__ void thin_phase(const ThinP p, const float* xin, const float* ctxin, float* X, float* CTXS, const bf16_t* Y, const float* YCP, int nks, bf16_t* XN, const float* MOD, const float* normg, int gw, int NGW, int lane) {
    asm volatile("" : "+v"(lane));
    for (int r0 = gw; r0 < ML; r0 += 4 * NGW) {
        const int r1 = r0 + NGW, r2 = r0 + 2 * NGW, r3 = r0 + 3 * NGW; const bool has1 = r1 < ML, has2 = r2 < ML, has3 = r3 < ML;
        f32x4 x0[4], y0[4], x1[4], y1[4], x2[4], y2[4], x3[4], y3[4];
        thin_load(p, r0, xin, ctxin, X, CTXS, Y, YCP, 0, lane, x0, y0);
        if (has1) thin_load(p, r1, xin, ctxin, X, CTXS, Y, YCP, 0, lane, x1, y1);
        if (has2) thin_load(p, r2, xin, ctxin, X, CTXS, Y, YCP, 0, lane, x2, y2);
        if (has3) thin_load(p, r3, xin, ctxin, X, CTXS, Y, YCP, 0, lane, x3, y3);
        const int bs0 = r0 >> 13;
        ThinVec tv; thin_vecs(p, bs0, MOD, normg, lane, tv);
        thin_row(p, r0, X, CTXS, XN, tv, lane, x0, y0);
        if (has1) { const int b1 = r1 >> 13; if (b1 != bs0) thin_vecs(p, b1, MOD, normg, lane, tv); thin_row(p, r1, X, CTXS, XN, tv, lane, x1, y1);
            if (has2) { const int b2 = r2 >> 13; if (b2 != b1) thin_vecs(p, b2, MOD, normg, lane, tv); thin_row(p, r2, X, CTXS, XN, tv, lane, x2, y2);
                if (has3) { const int b3 = r3 >> 13; if (b3 != b2) thin_vecs(p, b3, MOD, normg, lane, tv); thin_row(p, r3, X, CTXS, XN, tv, lane, x3, y3); } } }
    }
    if (nks >= 0) for (int r = ML + gw; r < R; r += NGW) {
        f32x4 x0[4], y0[4];
        thin_load(p, r, xin, ctxin, X, CTXS, Y, YCP, nks, lane, x0, y0);
        ThinVec tv; thin_vecs(p, 2, MOD, normg, lane, tv);
        thin_row(p, r, X, CTXS, XN, tv, lane, x0, y0);
    }
}

__device__ __forceinline__ int pos_row(int b, int P) { return (P < CTXL) ? ML + b * CTXL + P : b * SEQ + (P - CTXL); }
__device__ __forceinline__ size_t hbase(int b, int h, int c) { return ((size_t)(b * 4 + h) * NPOS + 64 * c) * 512; }
__device__ __forceinline__ int chunk_row0(int b, int c) { return (c < 4) ? ML + b * CTXL + 64 * c : b * SEQ + 64 * (c - 4); }

__device__ __forceinline__ void wcm_item(const float* wqkv, const float* wg, bf16_t* wcm, int idx) {
    const int li = idx >> 15, c = (idx >> 4) & 2047, g = idx & 15, n = c >> 2, i = c & 3;
    const float* wq = wqkv + ((size_t)(li * 3 + 0) * 512 + n) * 16; const float* wk = wqkv + ((size_t)(li * 3 + 1) * 512 + n) * 16; const float* wv = wqkv + ((size_t)(li * 3 + 2) * 512 + n) * 16;
    const float* G = wg + (size_t)li * 6144 * 16;
    float sc = 0.f, sm = 0.f;
#pragma unroll
    for (int o = 0; o < 4; ++o) { sc += wq[o * 4 + i] * G[(size_t)(4 * n + o) * 16 + g] + wk[o * 4 + i] * G[(size_t)(2048 + 4 * n + o) * 16 + g]; sm += wv[o * 4 + i] * G[(size_t)(4096 + 4 * n + o) * 16 + g]; }
    const int ks = c >> 5, ln = ((c >> 3) & 3) * 16 + g, jj = c & 7;
    wcm[(((size_t)li * 128 + ks) * 64 + ln) * 8 + jj] = f2bf(sc); wcm[(((size_t)li * 128 + 64 + ks) * 64 + ln) * 8 + jj] = f2bf(sm);
}
__device__ __forceinline__ void gates_tile(const bf16_t* XC, const bf16_t* XM, const bf16_t* wcmb, const float* bg, float* GATES, LAS float* red, int tile, int wave, int lane) {
    const int r0 = 16 * tile;
    const bf16_t* ac = XC + (size_t)(r0 + (lane & 15)) * DI + 8 * (lane >> 4) + 256 * wave; const bf16_t* am = XM + (size_t)(r0 + (lane & 15)) * DI + 8 * (lane >> 4) + 256 * wave;
    const bf16_t* bp = wcmb + (size_t)lane * 8 + (size_t)(8 * wave) * 512;
    bf16x8 a0[8], b0[8], a1[8], b1[8];
#pragma unroll
    for (int ks = 0; ks < 8; ++ks) { a0[ks] = *(const bf16x8*)(ac + 32 * ks); b0[ks] = *(const bf16x8*)(bp + (size_t)ks * 512); a1[ks] = *(const bf16x8*)(am + 32 * ks); b1[ks] = *(const bf16x8*)(bp + (size_t)(64 + ks) * 512); }
    f32x4 acc0 = {0.f, 0.f, 0.f, 0.f}, acc1 = acc0;
#pragma unroll
    for (int ks = 0; ks < 8; ++ks) { acc0 = mfma16(a0[ks], b0[ks], acc0); acc1 = mfma16(a1[ks], b1[ks], acc1); }
    *(LAS f32x4*)(red + wave * 256 + lane * 4) = acc0 + acc1;
    __syncthreads();
    if (wave == 0) { f32x4 t = *(const LAS f32x4*)(red + lane * 4);
#pragma unroll
        for (int w = 1; w < 8; ++w) t += *(const LAS f32x4*)(red + w * 256 + lane * 4);
        const float bb = bg[lane & 15];
#pragma unroll
        for (int rg = 0; rg < 4; ++rg) GATES[(size_t)(r0 + 4 * (lane >> 4) + rg) * 16 + (lane & 15)] = t[rg] + bb; }
    __syncthreads();
}

__device__ __forceinline__ void phase_a2(const bf16_t* XM, bf16_t* XC, bf16_t* Q, bf16_t* K, bf16_t* V, const float* convw, const float* convb, const float* wqkv, int vcu, int G, int wave, int lane) {
    asm volatile("" : "+v"(lane));
    const int c0 = 256 * wave + 4 * lane;
    f32x4 cw[9], cb, wb[3][4];
#pragma unroll
    for (int t = 0; t < 9; ++t) cw[t] = *(const f32x4*)(convw + (size_t)t * DI + c0);
    cb = *(const f32x4*)(convb + c0);
#pragma unroll
    for (int part = 0; part < 3; ++part)
#pragma unroll
        for (int o = 0; o < 4; ++o) wb[part][o] = *(const f32x4*)(wqkv + ((size_t)part * 512 + (c0 >> 2)) * 16 + 4 * o);
    u32x2 tp[3][6], tn[3][6];
#define A2_LOAD(dst, qi) do { const int r0_ = 4 * (qi); int rb_, gr_, gc_, nr_, nc_; \
        if (r0_ < ML) { const int b_ = r0_ >> 13, t0_ = r0_ & (SEQ - 1); rb_ = b_ * SEQ; gr_ = t0_ >> 6; gc_ = t0_ & 63; nr_ = SEQ / 64; nc_ = 64; } \
        else { const int b_ = (r0_ - ML) >> 8; rb_ = ML + b_ * CTXL; gr_ = 0; gc_ = (r0_ - ML) & (CTXL - 1); nr_ = 1; nc_ = CTXL; } \
        _Pragma("unroll") for (int dr = 0; dr < 3; ++dr) { const int rr = gr_ + dr - 1; const bool rok = (rr >= 0) && (rr < nr_); \
            _Pragma("unroll") for (int dc = 0; dc < 6; ++dc) { const int cc = gc_ + dc - 1; const bool ok = rok && (cc >= 0) && (cc < nc_); \
                u32x2 w_ = {0u, 0u}; if (ok) w_ = *(const u32x2*)(XM + (size_t)(rb_ + rr * nc_ + cc) * DI + c0); dst[dr][dc] = w_; } } } while (0)
    int qi = vcu;
    if (qi < R / 4) A2_LOAD(tp, qi);
    for (; qi < R / 4; qi += G) {
        const int qn = qi + G;
        if (qn < R / 4) A2_LOAD(tn, qn);
        const int r0 = 4 * qi;
        const int hb4 = (r0 < ML) ? (r0 >> 13) * 4 : ((r0 - ML) >> 8) * 4, P0 = (r0 < ML) ? CTXL + (r0 & (SEQ - 1)) : ((r0 - ML) & (CTXL - 1));
#pragma unroll
        for (int tk = 0; tk < 4; ++tk) {
            f32x4 a = cb;
#pragma unroll
            for (int dr = 0; dr < 3; ++dr)
#pragma unroll
                for (int dc = 0; dc < 3; ++dc) { const u32x2 w = tp[dr][tk + dc]; a += cw[dr * 3 + dc] * (f32x4){bflo(w.x), bfhi(w.x), bflo(w.y), bfhi(w.y)}; }
            const f32x4 xc = {silu_f(a.x), silu_f(a.y), silu_f(a.z), silu_f(a.w)};
            const u32x2 wm = tp[1][tk + 1]; const f32x4 xm = {bflo(wm.x), bfhi(wm.x), bflo(wm.y), bfhi(wm.y)};
            { u32x2 o; o.x = cvtpk(xc.x, xc.y); o.y = cvtpk(xc.z, xc.w); *(u32x2*)(XC + (size_t)(r0 + tk) * DI + c0) = o; }
#pragma unroll
            for (int part = 0; part < 3; ++part) {
                const f32x4 sv = (part == 2) ? xm : xc; float o4[4];
#pragma unroll
                for (int o = 0; o < 4; ++o) { const f32x4 pr = wb[part][o] * sv; o4[o] = (pr.x + pr.y) + (pr.z + pr.w); }
                const float osc = (part == 1) ? 0.04419417382415922f : 1.0f;
                u32x2 ow; ow.x = cvtpk(o4[0] * osc, o4[1] * osc); ow.y = cvtpk(o4[2] * osc, o4[3] * osc);
                bf16_t* dst = (part == 0) ? Q : (part == 1) ? K : V;
                *(u32x2*)(dst + ((size_t)(hb4 + (c0 >> 9)) * NPOS + P0 + tk) * 512 + (c0 & 511)) = ow;
            }
        }
#pragma unroll
        for (int dr = 0; dr < 3; ++dr)
#pragma unroll
            for (int dc = 0; dc < 6; ++dc) tp[dr][dc] = tn[dr][dc];
    }
#undef A2_LOAD
}

__device__ __forceinline__ float wave_incl_sum(float v, int lane) {
#pragma unroll
    for (int o = 1; o < 64; o <<= 1) { const float t = __shfl_up(v, o); if (lane >= o) v += t; }
    return v;
}
__device__ __forceinline__ float wave_incl_max(float v, int lane) {
#pragma unroll
    for (int o = 1; o < 64; o <<= 1) { const float t = __shfl_up(v, o); if (lane >= o) v = fmaxf(v, t); }
    return v;
}
__device__ __forceinline__ float logsigmoid_f(float x) { return fminf(x, 0.f) - log1pf(__expf(-fabsf(x))); }
__device__ __forceinline__ int stream_chunk(int dir, int sc) { return dir ? ((sc < 4) ? 3 - sc : 135 - sc) : sc; }

__device__ __forceinline__ void gate_scan(const float* GATES, float* GM, LAS float* Bl, LAS float* Al, LAS float* Il, LAS float* tot, LAS float* mxs, int s, bool store_gm, int wave, int lane) {
    const int dir = s >> 3, b = (s >> 2) & 1, h = s & 3;
    constexpr int NPW = (NCHUNK + NWAVES - 1) / NWAVES;
    float gfv[NPW], giv[NPW];
#pragma unroll
    for (int q = 0; q < NPW; ++q) { const int sc = wave + NWAVES * q; gfv[q] = 0.f; giv[q] = 0.f;
        if (sc < NCHUNK) { const int c = stream_chunk(dir, sc), P = 64 * c + (dir ? 63 - lane : lane), row = pos_row(b, P);
            gfv[q] = GATES[(size_t)row * 16 + (dir * 2 + 1) * 4 + h]; giv[q] = GATES[(size_t)row * 16 + (dir * 2 + 0) * 4 + h]; } }
#pragma unroll
    for (int q = 0; q < NPW; ++q) { const int sc = wave + NWAVES * q;
        if (sc < NCHUNK) { const float ps = wave_incl_sum(logsigmoid_f(gfv[q]), lane); Bl[sc * 64 + lane] = ps; if (lane == 63) tot[sc] = ps; } }
    __syncthreads();
    if (wave == 0) { float carry = 0.f;
        for (int i0 = 0; i0 < NCHUNK; i0 += 64) { const int i = i0 + lane; const float v = (i < NCHUNK) ? tot[i] : 0.f; const float inc = wave_incl_sum(v, lane);
            if (i < NCHUNK) tot[i] = carry + inc - v; carry += __shfl(inc, 63); } }
    __syncthreads();
#pragma unroll
    for (int q = 0; q < NPW; ++q) { const int sc = wave + NWAVES * q;
        if (sc < NCHUNK) { const float gi = giv[q]; const float B = Bl[sc * 64 + lane] + tot[sc]; const float pm = wave_incl_max(gi - B, lane);
            Bl[sc * 64 + lane] = B; Al[sc * 64 + lane] = pm; Il[sc * 64 + lane] = gi; if (lane == 63) mxs[sc] = pm; } }
    __syncthreads();
    if (wave == 0) { float carry = 0.f;
        for (int i0 = 0; i0 < NCHUNK; i0 += 64) { const int i = i0 + lane; const float v = (i < NCHUNK) ? mxs[i] : -3.0e38f; const float inc = wave_incl_max(v, lane);
            float ex = __shfl_up(inc, 1); if (lane == 0) ex = -3.0e38f; ex = fmaxf(ex, carry);
            if (i < NCHUNK) mxs[i] = ex; carry = fmaxf(carry, __shfl(inc, 63)); } }
    __syncthreads();
    for (int sc = wave; sc < NCHUNK; sc += NWAVES) {
        const int c = stream_chunk(dir, sc), P = 64 * c + (dir ? 63 - lane : lane);
        const float m = Bl[sc * 64 + lane] + fmaxf(mxs[sc], Al[sc * 64 + lane]);
        Al[sc * 64 + lane] = m; if (store_gm) GM[(size_t)s * NPOS + P] = m;
    }
    __syncthreads();
}

__device__ __forceinline__ void phase_a3(bf16_t* Q, bf16_t* K, bf16_t* V, bf16_t* SRAW, const bf16_t* XC, const bf16_t* XM, const bf16_t* wcmb, const float* bg, float* GATES, LAS unsigned char* lds, int vcu, int G, int tid, int wave, int lane) {
    asm volatile("" : "+v"(tid), "+v"(lane));
    constexpr int PITCH = 520;
    LAS bf16_t* KL = (LAS bf16_t*)lds;
    LAS bf16_t* QL = KL + 64 * PITCH;
    for (int t16 = (vcu + G / 2) % G; t16 < R / 16; t16 += G) gates_tile(       XC, XM, wcmb, bg, GATES, (LAS float*)lds, t16, wave, lane);
#define A3_BAR() do { asm volatile("s_waitcnt lgkmcnt(0)" ::: "memory"); __builtin_amdgcn_s_barrier(); asm volatile("" ::: "memory"); } while (0)
#define A3_PTRS(u) const int bh_ = (u) / NCHUNK, c_ = (u) % NCHUNK, b_ = bh_ >> 2, h_ = bh_ & 3; \
        const size_t hb_ = hbase(b_, h_, c_); bf16_t* Kp = K + hb_; bf16_t* Qp = Q + hb_; bf16_t* Vp = V + hb_;
    u32x4 kr[8], qr[8], vr[8];
    const int sr0 = tid >> 6, kc = tid & 63;
    int unit = vcu;
    if (unit < 8 * NCHUNK) { A3_PTRS(unit)
#pragma unroll
        for (int i = 0; i < 8; ++i) { kr[i] = *(const u32x4*)(Kp + (size_t)(sr0 + 8 * i) * 512 + 8 * kc); qr[i] = *(const u32x4*)(Qp + (size_t)(sr0 + 8 * i) * 512 + 8 * kc); vr[i] = *(const u32x4*)(Vp + (size_t)(sr0 + 8 * i) * 512 + 8 * kc); } }
    for (; unit < 8 * NCHUNK; unit += G) {
        A3_PTRS(unit)
        const int nu = unit + G; const bool hn = nu < 8 * NCHUNK;
#pragma unroll
        for (int i = 0; i < 8; ++i) { *(LAS u32x4*)(KL + (sr0 + 8 * i) * PITCH + 8 * kc) = kr[i]; *(LAS u32x4*)(QL + (sr0 + 8 * i) * PITCH + 8 * kc) = qr[i]; }
        if (hn) { const int bh2 = nu / NCHUNK, c2 = nu % NCHUNK; const size_t hb2 = hbase(bh2 >> 2, bh2 & 3, c2); const bf16_t* Kn = K + hb2; const bf16_t* Qn = Q + hb2;
#pragma unroll
            for (int i = 0; i < 8; ++i) { kr[i] = *(const u32x4*)(Kn + (size_t)(sr0 + 8 * i) * 512 + 8 * kc); qr[i] = *(const u32x4*)(Qn + (size_t)(sr0 + 8 * i) * 512 + 8 * kc); } }
        A3_BAR();
#pragma unroll
        for (int i = 0; i < 8; ++i) { const int T = wave * 8 + i, ktg = T >> 1, ks = T & 1;
            unsigned short e[8];
#pragma unroll
            for (int q = 0; q < 8; ++q) e[q] = KL[(32 * ks + 8 * (lane >> 4) + q) * PITCH + 16 * ktg + (lane & 15)];
            u32x4 w; w.x = e[0] | ((unsigned)e[1] << 16); w.y = e[2] | ((unsigned)e[3] << 16); w.z = e[4] | ((unsigned)e[5] << 16); w.w = e[6] | ((unsigned)e[7] << 16);
            *(u32x4*)(Kp + (size_t)T * 512 + 8 * lane) = w; }
        {
            const int tt = wave >> 1, st0 = 2 * (wave & 1);
            f32x4 acc0 = {0.f, 0.f, 0.f, 0.f}, acc1 = acc0;
#pragma unroll
            for (int ks = 0; ks < 16; ++ks) { const bf16x8 a = *(const LAS bf16x8*)(QL + (16 * tt + (lane & 15)) * PITCH + 32 * ks + 8 * (lane >> 4));
                const bf16x8 b0 = *(const LAS bf16x8*)(KL + (16 * st0 + (lane & 15)) * PITCH + 32 * ks + 8 * (lane >> 4)), b1 = *(const LAS bf16x8*)(KL + (16 * st0 + 16 + (lane & 15)) * PITCH + 32 * ks + 8 * (lane >> 4));
                acc0 = mfma16(a, b0, acc0); acc1 = mfma16(a, b1, acc1);
                if ((ks & 1) == (wave & 1)) {
                    const LAS bf16_t* qrow = QL + (16 * tt + (lane & 15)) * PITCH + 32 * ks + 4 * (lane >> 4);
                    const u32x2 lo = *(const LAS u32x2*)qrow, hi = *(const LAS u32x2*)(qrow + 16);
                    u32x4 pk; pk.x = lo.x; pk.y = lo.y; pk.z = hi.x; pk.w = hi.y;
                    *(u32x4*)(Qp + (size_t)(tt * 16 + ks) * 512 + 8 * lane) = pk; } }
            bf16_t* sp = SRAW + (size_t)unit * 4096 + (16 * tt + 4 * (lane >> 4)) * 64 + 16 * st0 + (lane & 15);
#pragma unroll
            for (int rg = 0; rg < 4; ++rg) { sp[rg * 64] = f2bf(acc0[rg]); sp[rg * 64 + 16] = f2bf(acc1[rg]); }
        }
        A3_BAR();
#pragma unroll
        for (int i = 0; i < 8; ++i) *(LAS u32x4*)(KL + (sr0 + 8 * i) * PITCH + 8 * kc) = vr[i];
        if (hn) { const int bh2 = nu / NCHUNK, c2 = nu % NCHUNK; const bf16_t* Vn = V + hbase(bh2 >> 2, bh2 & 3, c2);
#pragma unroll
            for (int i = 0; i < 8; ++i) vr[i] = *(const u32x4*)(Vn + (size_t)(sr0 + 8 * i) * 512 + 8 * kc); }
        A3_BAR();
#pragma unroll
        for (int i = 0; i < 8; ++i) { const int piece = tid + NTHREADS * i, sg = piece >> 9, k = piece & 511;
            unsigned short e[8];
#pragma unroll
            for (int q = 0; q < 8; ++q) e[q] = KL[(8 * sg + q) * PITCH + k];
            u32x4 w; w.x = e[0] | ((unsigned)e[1] << 16); w.y = e[2] | ((unsigned)e[3] << 16); w.z = e[4] | ((unsigned)e[5] << 16); w.w = e[6] | ((unsigned)e[7] << 16);
            *(u32x4*)(Vp + (size_t)(k >> 3) * 512 + (k & 7) * 64 + 8 * sg) = w; }
        A3_BAR();
    }
    __syncthreads();
#undef A3_BAR
#undef A3_PTRS
}

constexpr int TABW = 320;
__device__ __forceinline__ void phase_a3bc(const float* GATES, const bf16_t* SRAW, bf16_t* SDT, float* TAB, float* GM, LAS unsigned char* lds, int vcu, int tid, int wave, int lane) {
    asm volatile("" : "+v"(tid), "+v"(lane));
    LAS float* Bl = (LAS float*)lds; LAS float* Ml = Bl + NPOS; LAS float* Il = Ml + NPOS; LAS float* tot = Il + NPOS; LAS float* mxs = tot + 192;
    const int s = vcu >> 4, jj = vcu & 15, dir = s >> 3, b = (s >> 2) & 1, h = s & 3;
    gate_scan(GATES, GM, Bl, Ml, Il, tot, mxs, s, jj == 0, wave, lane);
    const int tt = wave >> 1, ks = wave & 1, t = 16 * tt + (lane & 15), s0 = 32 * ks + 8 * (lane >> 4);
    u32x4 swn = *(const u32x4*)(SRAW + ((size_t)((b * 4 + h) * NCHUNK + stream_chunk(dir, jj))) * 4096 + t * 64 + s0);
    for (int sc = jj; sc < NCHUNK; sc += 16) {
        const int c = stream_chunk(dir, sc);
        const u32x4 sw = swn;
        if (sc + 16 < NCHUNK) swn = *(const u32x4*)(SRAW + ((size_t)((b * 4 + h) * NCHUNK + stream_chunk(dir, sc + 16))) * 4096 + t * 64 + s0);
        const int tp = sc * 64 + (dir ? 63 - t : t);
        const float ct = Bl[tp] - Ml[tp];
        const float sv[8] = {bflo(sw.x), bfhi(sw.x), bflo(sw.y), bfhi(sw.y), bflo(sw.z), bfhi(sw.z), bflo(sw.w), bfhi(sw.w)};
        float d[8], acc = 0.f;
#pragma unroll
        for (int e = 0; e < 8; ++e) { const int ss = s0 + e, sp = sc * 64 + (dir ? 63 - ss : ss); const bool ok = dir ? (ss >= t) : (ss <= t);
            d[e] = sv[e] * __expf(ok ? (ct + Il[sp] - Bl[sp]) : -1.0e30f); acc += d[e]; }
        u32x4 o; o.x = cvtpk(d[0], d[1]); o.y = cvtpk(d[2], d[3]); o.z = cvtpk(d[4], d[5]); o.w = cvtpk(d[6], d[7]);
        *(u32x4*)(SDT + (((size_t)s * NCHUNK + c) * 8 + wave) * 512 + lane * 8) = o;
        acc += __shfl_xor(acc, 16); acc += __shfl_xor(acc, 32);
        float* tab = TAB + ((size_t)s * NCHUNK + c) * TABW;
        if (lane < 16) tab[128 + 64 * ks + t] = acc;
        if (wave < 2) {
            const int lp = sc * 64 + 63; const float dl = Bl[lp] - Ml[lp]; const float dp = (sc > 0) ? (Bl[sc * 64 - 1] - Ml[sc * 64 - 1]) : 0.f;
            const int pp = sc * 64 + (dir ? 63 - lane : lane);
            if (wave == 0) { tab[lane] = __expf(Bl[pp] - Ml[pp] - dp); if (lane == 0) tab[256] = __expf(dl - dp); }
            else tab[64 + lane] = __expf(dl + Il[pp] - Bl[pp]);
        }
    }
    __syncthreads();
}

__device__ __forceinline__ void phase_a4(const bf16_t* Q, const bf16_t* KT, const bf16_t* VT, const bf16_t* SDT, const float* TAB, bf16_t* NUMF, bf16_t* NUMB, float* PD,
                                         LAS unsigned char* lds, int vcu, int tid, int wave, int lane) {
    asm volatile("" : "+v"(tid), "+v"(lane));
    constexpr int SP = 72, RP = 36;
    LAS float* red = (LAS float*)lds;
    LAS bf16_t* VtL = (LAS bf16_t*)(red + 9 * 64 * RP);
    LAS bf16_t* VwL = VtL + 2 * 32 * SP;
    LAS float* nL = (LAS float*)(VwL + 2 * 32 * SP);
    const int s = vcu >> 4, j = vcu & 15, dir = s >> 3, b = (s >> 2) & 1, h = s & 3;
    bf16_t* NUM = dir ? NUMB : NUMF;
    const int tt = wave >> 1, vt = wave & 1, g = lane >> 4;
    f32x4 cacc[4][2];
#pragma unroll
    for (int kt = 0; kt < 4; ++kt)
#pragma unroll
        for (int v2 = 0; v2 < 2; ++v2) cacc[kt][v2] = (f32x4){0.f, 0.f, 0.f, 0.f};
    if (tid < 32) nL[tid] = 0.f;
    const int st_t = tid >> 3, kq = tid & 7;
    const int sv_v = (tid & 255) >> 3, sv_s0 = 8 * kq;
    const int nk = tid >> 4, nsq = tid & 15;
    bf16x8 qf[4][2], ktf[2][4], sdf[2]; u32x4 vtw; u32x2 q4w, kt4w; f32x4 wv0, wv1, wn4; float rs0, rs1, sct, dec;
#define A4_CH(stp) stream_chunk(dir, (stp))
#define A4_LOAD_STAGE(stp) do { const int c_ = A4_CH(stp), r_ = chunk_row0(b, c_); const float* tb_ = TAB + ((size_t)s * NCHUNK + c_) * TABW; \
        { const int vv = 32 * j + sv_v; vtw = *(const u32x4*)(VT + hbase(b, h, c_) + (size_t)(vv >> 3) * 512 + (vv & 7) * 64 + sv_s0); } \
        wv0 = *(const f32x4*)(tb_ + 64 + sv_s0); wv1 = *(const f32x4*)(tb_ + 64 + sv_s0 + 4); } while (0)
#define A4_LOAD_H(stp) do { const int c_ = A4_CH(stp), r_ = chunk_row0(b, c_); const float* tb_ = TAB + ((size_t)s * NCHUNK + c_) * TABW; \
        _Pragma("unroll") for (int i = 0; i < 4; ++i) _Pragma("unroll") for (int kp = 0; kp < 2; ++kp) \
            qf[i][kp] = *(const bf16x8*)(Q + hbase(b, h, c_) + (size_t)(16 * i + 2 * wave + kp) * 512 + 8 * lane); \
        _Pragma("unroll") for (int ks = 0; ks < 2; ++ks) sdf[ks] = *(const bf16x8*)(SDT + (((size_t)s * NCHUNK + c_) * 8 + 2 * tt + ks) * 512 + lane * 8); \
        q4w = *(const u32x2*)(Q + hbase(b, h, c_) + (size_t)((st_t >> 4) * 16 + j) * 512 + ((st_t & 15) + 16 * (kq & 3)) * 8 + 4 * (kq >> 2)); \
        sct = tb_[st_t]; rs0 = tb_[128 + st_t]; rs1 = tb_[192 + st_t]; } while (0)
#define A4_LOAD_K(stp) do { const int c_ = A4_CH(stp), r_ = chunk_row0(b, c_); const float* tb_ = TAB + ((size_t)s * NCHUNK + c_) * TABW; \
        _Pragma("unroll") for (int ks = 0; ks < 2; ++ks) _Pragma("unroll") for (int kt = 0; kt < 4; ++kt) \
            ktf[ks][kt] = *(const bf16x8*)(KT + hbase(b, h, c_) + (size_t)((4 * wave + kt) * 2 + ks) * 512 + 8 * lane); \
        kt4w = *(const u32x2*)(KT + hbase(b, h, c_) + (size_t)((2 * j + (nk >> 4)) * 2 + (nsq >> 3)) * 512 + ((nk & 15) + 16 * ((nsq >> 1) & 3)) * 8 + 4 * (nsq & 1)); \
        wn4 = *(const f32x4*)(tb_ + 64 + 4 * nsq); dec = tb_[256]; } while (0)
#define A4_STAGE_V(pb) do { *(LAS u32x4*)(VtL + ((pb) * 32 + sv_v) * SP + sv_s0) = vtw; \
        u32x4 ow; ow.x = cvtpk(bflo(vtw.x) * wv0.x, bfhi(vtw.x) * wv0.y); ow.y = cvtpk(bflo(vtw.y) * wv0.z, bfhi(vtw.y) * wv0.w); \
        ow.z = cvtpk(bflo(vtw.z) * wv1.x, bfhi(vtw.z) * wv1.y); ow.w = cvtpk(bflo(vtw.w) * wv1.z, bfhi(vtw.w) * wv1.w); \
        *(LAS u32x4*)(VwL + ((pb) * 32 + sv_v) * SP + sv_s0) = ow; } while (0)
#define A4_BAR() do { asm volatile("s_waitcnt lgkmcnt(0)" ::: "memory"); __builtin_amdgcn_s_barrier(); asm volatile("" ::: "memory"); } while (0)
    A4_LOAD_STAGE(0);
    A4_STAGE_V(0);
    __builtin_amdgcn_sched_barrier(0);
    A4_LOAD_STAGE(1);
    __builtin_amdgcn_sched_barrier(0);
    A4_LOAD_H(0);
    __builtin_amdgcn_sched_barrier(0);
    A4_LOAD_K(0);
    __builtin_amdgcn_sched_barrier(0);
    A4_BAR();
#pragma unroll 1
    for (int step = 0; step < NCHUNK; ++step) {
        const int p = step & 1;
        const int c = A4_CH(step), row0 = chunk_row0(b, c);
        const int nxt = (step + 1 < NCHUNK) ? step + 1 : step, nx2 = (step + 2 < NCHUNK) ? step + 2 : NCHUNK - 1;
        A4_STAGE_V(p ^ 1);
        __builtin_amdgcn_sched_barrier(0);
        A4_LOAD_STAGE(nx2);
        __builtin_amdgcn_sched_barrier(0);
        {
            bf16x8 bst[2][2];
#pragma unroll
            for (int kp = 0; kp < 2; ++kp)
#pragma unroll
                for (int v2 = 0; v2 < 2; ++v2) { u32x4 pk; pk.x = cvtpk(cacc[2 * kp][v2][0], cacc[2 * kp][v2][1]); pk.y = cvtpk(cacc[2 * kp][v2][2], cacc[2 * kp][v2][3]);
                    pk.z = cvtpk(cacc[2 * kp + 1][v2][0], cacc[2 * kp + 1][v2][1]); pk.w = cvtpk(cacc[2 * kp + 1][v2][2], cacc[2 * kp + 1][v2][3]); bst[kp][v2] = __builtin_bit_cast(bf16x8, pk); }
#pragma unroll
            for (int i = 0; i < 4; ++i)
#pragma unroll
                for (int v2 = 0; v2 < 2; ++v2) { f32x4 hp = {0.f, 0.f, 0.f, 0.f};
#pragma unroll
                    for (int kp = 0; kp < 2; ++kp) hp = mfma16(qf[i][kp], bst[kp][v2], hp);
                    LAS float* rp = red + (wave * 64 + 16 * i + 4 * g) * RP + 16 * v2 + (lane & 15);
                    rp[0] = hp[0]; rp[RP] = hp[1]; rp[2 * RP] = hp[2]; rp[3 * RP] = hp[3]; }
            f32x4 a2 = {0.f, 0.f, 0.f, 0.f};
#pragma unroll
            for (int ks = 0; ks < 2; ++ks) { const bf16x8 bb = *(const LAS bf16x8*)(VtL + (p * 32 + 16 * vt + (lane & 15)) * SP + 32 * ks + 8 * (lane >> 4)); a2 = mfma16(sdf[ks], bb, a2); }
            LAS float* ip = red + (8 * 64 + 16 * tt + 4 * g) * RP + 16 * vt + (lane & 15);
            ip[0] = a2[0]; ip[RP] = a2[1]; ip[2 * RP] = a2[2]; ip[3 * RP] = a2[3];
        }
        {
            const LAS float* nl = nL + 32 * p;
            float acc = bflo(q4w.x) * nl[4 * kq] + bfhi(q4w.x) * nl[4 * kq + 1] + bflo(q4w.y) * nl[4 * kq + 2] + bfhi(q4w.y) * nl[4 * kq + 3];
            acc += __shfl_xor(acc, 1); acc += __shfl_xor(acc, 2); acc += __shfl_xor(acc, 4);
            if (kq == 0) PD[((size_t)s * NPOS + 64 * c + st_t) * 16 + j] = sct * acc + ((j == 0) ? (rs0 + rs1) : 0.f);
        }
        const float sct_cur = sct;
        __builtin_amdgcn_sched_barrier(0);
        A4_LOAD_H(nxt);
        __builtin_amdgcn_sched_barrier(0);
        const float decay = dec;
#pragma unroll
        for (int kt = 0; kt < 4; ++kt)
#pragma unroll
            for (int v2 = 0; v2 < 2; ++v2) cacc[kt][v2] *= decay;
#pragma unroll
        for (int ks = 0; ks < 2; ++ks) {
            bf16x8 bw[2];
#pragma unroll
            for (int v2 = 0; v2 < 2; ++v2) bw[v2] = *(const LAS bf16x8*)(VwL + (p * 32 + 16 * v2 + (lane & 15)) * SP + 32 * ks + 8 * (lane >> 4));
#pragma unroll
            for (int kt = 0; kt < 4; ++kt)
#pragma unroll
                for (int v2 = 0; v2 < 2; ++v2) cacc[kt][v2] = mfma16(ktf[ks][kt], bw[v2], cacc[kt][v2]);
        }
        float nacc;
        {
            float acc = bflo(kt4w.x) * wn4.x + bfhi(kt4w.x) * wn4.y + bflo(kt4w.y) * wn4.z + bfhi(kt4w.y) * wn4.w;
            acc += __shfl_xor(acc, 1); acc += __shfl_xor(acc, 2); acc += __shfl_xor(acc, 4); acc += __shfl_xor(acc, 8);
            nacc = decay * nL[32 * p + nk] + acc;
        }
        __builtin_amdgcn_sched_barrier(0);
        A4_LOAD_K(nxt);
        __builtin_amdgcn_sched_barrier(0);
        A4_BAR();
        if (nsq == 0) nL[32 * (p ^ 1) + nk] = nacc;
        {
            const LAS float* rp = red + st_t * RP + 4 * kq;
            f32x4 sum = *(const LAS f32x4*)rp;
#pragma unroll
            for (int w = 1; w < 8; ++w) sum += *(const LAS f32x4*)(rp + w * 64 * RP);
            const f32x4 hv = sum * sct_cur + *(const LAS f32x4*)(rp + 8 * 64 * RP);
            u32x2 o; o.x = cvtpk(hv.x, hv.y); o.y = cvtpk(hv.z, hv.w);
            *(u32x2*)(NUM + (size_t)(row0 + st_t) * DI + h * DH + 32 * j + 4 * kq) = o;
        }
        A4_BAR();
    }
    __syncthreads();
#undef A4_CH
#undef A4_LOAD_STAGE
#undef A4_LOAD_H
#undef A4_LOAD_K
#undef A4_STAGE_V
#undef A4_BAR
}

struct A5Row { u32x4 wf[4], wb[4], wx[4], wz[4]; float df, db, mf, mb; };
__device__ __forceinline__ void a5_load(A5Row& d, int r, const bf16_t* NUMF, const bf16_t* NUMB, const float* PD, const float* GM, const bf16_t* XC, const bf16_t* Z, int lane) {
    int b, P; if (r < ML) { b = r >> 13; P = CTXL + (r & (SEQ - 1)); } else { b = (r - ML) >> 8; P = (r - ML) & (CTXL - 1); }
#pragma unroll
    for (int h = 0; h < 4; ++h) { const int c0 = h * DH + 8 * lane;
        d.wf[h] = *(const u32x4*)(NUMF + (size_t)r * DI + c0); d.wb[h] = *(const u32x4*)(NUMB + (size_t)r * DI + c0); d.wx[h] = *(const u32x4*)(XC + (size_t)r * DI + c0); d.wz[h] = *(const u32x4*)(Z + (size_t)r * DI + c0); }
    const int hh = lane >> 4, jj = lane & 15, sf = b * 4 + hh, sb = 8 + b * 4 + hh;
    d.df = PD[((size_t)sf * NPOS + P) * 16 + jj]; d.db = PD[((size_t)sb * NPOS + P) * 16 + jj];
    d.mf = GM[(size_t)sf * NPOS + P]; d.mb = GM[(size_t)sb * NPOS + P];
}
__device__ __forceinline__ void a5_row(const A5Row& d, int r, bf16_t* G, const float* ang, const float* askip, int lane) {
    float df = d.df, db = d.db;
#pragma unroll
    for (int o = 1; o < 16; o <<= 1) { df += __shfl_xor(df, o); db += __shfl_xor(db, o); }
    const float nfl = 1.0f / fmaxf(fabsf(df), __expf(-d.mf)), nbl = 1.0f / fmaxf(fabsf(db), __expf(-d.mb));
    float hv[4][8], sm[4], sq[4];
#pragma unroll
    for (int h = 0; h < 4; ++h) {
        const float nf = __shfl(nfl, 16 * h), nb = __shfl(nbl, 16 * h);
        const u32x4 a = d.wf[h], c = d.wb[h];
        hv[h][0] = bflo(a.x) * nf + bflo(c.x) * nb; hv[h][1] = bfhi(a.x) * nf + bfhi(c.x) * nb; hv[h][2] = bflo(a.y) * nf + bflo(c.y) * nb; hv[h][3] = bfhi(a.y) * nf + bfhi(c.y) * nb;
        hv[h][4] = bflo(a.z) * nf + bflo(c.z) * nb; hv[h][5] = bfhi(a.z) * nf + bfhi(c.z) * nb; hv[h][6] = bflo(a.w) * nf + bflo(c.w) * nb; hv[h][7] = bfhi(a.w) * nf + bfhi(c.w) * nb;
        float s1 = 0.f, s2 = 0.f;
#pragma unroll
        for (int e = 0; e < 8; ++e) { s1 += hv[h][e]; s2 += hv[h][e] * hv[h][e]; }
        sm[h] = s1; sq[h] = s2;
    }
#pragma unroll
    for (int o = 1; o < 64; o <<= 1)
#pragma unroll
        for (int h = 0; h < 4; ++h) { sm[h] += __shfl_xor(sm[h], o); sq[h] += __shfl_xor(sq[h], o); }
#pragma unroll
    for (int h = 0; h < 4; ++h) {
        const int c0 = h * DH + 8 * lane;
        const float mu = sm[h] * (1.0f / DH); const float var = fmaxf(sq[h] * (1.0f / DH) - mu * mu, 0.f); const float rstd = 1.0f / sqrtf(var + EPS);
        const u32x4 x4 = d.wx[h], z4 = d.wz[h];
        const float xc[8] = {bflo(x4.x), bfhi(x4.x), bflo(x4.y), bfhi(x4.y), bflo(x4.z), bfhi(x4.z), bflo(x4.w), bfhi(x4.w)};
        const float zz[8] = {bflo(z4.x), bfhi(z4.x), bflo(z4.y), bfhi(z4.y), bflo(z4.z), bfhi(z4.z), bflo(z4.w), bfhi(z4.w)};
        const f32x4 g0 = *(const f32x4*)(ang + c0), g1 = *(const f32x4*)(ang + c0 + 4), k0 = *(const f32x4*)(askip + c0), k1 = *(const f32x4*)(askip + c0 + 4);
        const float gg[8] = {g0.x, g0.y, g0.z, g0.w, g1.x, g1.y, g1.z, g1.w}, kk[8] = {k0.x, k0.y, k0.z, k0.w, k1.x, k1.y, k1.z, k1.w};
        float o[8];
#pragma unroll
        for (int e = 0; e < 8; ++e) o[e] = ((hv[h][e] - mu) * rstd * gg[e] + kk[e] * xc[e]) * silu_f(zz[e]);
        u32x4 w; w.x = cvtpk(o[0], o[1]); w.y = cvtpk(o[2], o[3]); w.z = cvtpk(o[4], o[5]); w.w = cvtpk(o[6], o[7]);
        *(u32x4*)(G + (size_t)r * DI + c0) = w;
    }
}
__device__ __forceinline__ void phase_a5(const bf16_t* NUMF, const bf16_t* NUMB, const float* PD, const float* GM, const bf16_t* XC, const bf16_t* Z, bf16_t* G, const float* ang, const float* askip, int nrows, int gw, int NGW, int lane) {
    asm volatile("" : "+v"(lane));
    for (int r0 = gw; r0 < nrows; r0 += 2 * NGW) {
        const int r1 = r0 + NGW; const bool has1 = r1 < nrows;
        A5Row d0, d1;
        a5_load(d0, r0, NUMF, NUMB, PD, GM, XC, Z, lane);
        if (has1) a5_load(d1, r1, NUMF, NUMB, PD, GM, XC, Z, lane);
        a5_row(d0, r0, G, ang, askip, lane);
        if (has1) a5_row(d1, r1, G, ang, askip, lane);
    }
}

__device__ __forceinline__ void phase_g2(bf16_t* U, const bf16_t* V, const float* vst, const float* lng, const float* lnb, const float* Ws, const float* bs, int nchunks, LAS unsigned char* lds, int vcu, int G, int tid, int wave, int lane) {
    asm volatile("" : "+v"(tid), "+v"(lane));
    constexpr int VP = 136;
    LAS bf16_t* VT = (LAS bf16_t*)lds;
    LAS float* mu = (LAS float*)(VT + 384 * VP); LAS float* rsd = mu + 128;
    for (int unit = vcu; unit < nchunks * 8; unit += G) {
        const int c = unit >> 3, g = unit & 7, r0 = 128 * c, e0 = 384 * g;
        if (tid < 128) { float s = 0.f, q = 0.f; const float* p = vst + (size_t)(r0 + tid) * 96;
#pragma unroll 8
            for (int i = 0; i < 48; ++i) { const f32x2 v = *(const f32x2*)(p + 2 * i); s += v.x; q += v.y; }
            const float m = s * (1.0f / EH); const float var = fmaxf(q * (1.0f / EH) - m * m, 0.f); mu[tid] = m; rsd[tid] = 1.0f / sqrtf(var + EPS); }
        __syncthreads();
#pragma unroll 1
        for (int i = 0; i < 12; ++i) { const int piece = tid + NTHREADS * i, q = piece & 127, ep = piece >> 7;
            const u32x4 w = *(const u32x4*)(V + (size_t)(r0 + q) * EH + e0 + 8 * ep);
            const f32x4 g0 = *(const f32x4*)(lng + e0 + 8 * ep), g1 = *(const f32x4*)(lng + e0 + 8 * ep + 4), b0 = *(const f32x4*)(lnb + e0 + 8 * ep), b1 = *(const f32x4*)(lnb + e0 + 8 * ep + 4);
            const float m = mu[q], rr = rsd[q];
            const float v[8] = {bflo(w.x), bfhi(w.x), bflo(w.y), bfhi(w.y), bflo(w.z), bfhi(w.z), bflo(w.w), bfhi(w.w)};
            const float gg[8] = {g0.x, g0.y, g0.z, g0.w, g1.x, g1.y, g1.z, g1.w}, bb[8] = {b0.x, b0.y, b0.z, b0.w, b1.x, b1.y, b1.z, b1.w};
#pragma unroll
            for (int e = 0; e < 8; ++e) VT[(8 * ep + e) * VP + q] = f2bf((v[e] - m) * rr * gg[e] + bb[e]); }
        __syncthreads();
        bf16x8 bfr[4];
        { const float* wp = Ws + ((size_t)g * 128 + 16 * wave + (lane & 15)) * 128 + 8 * (lane >> 4);
#pragma unroll
          for (int ks = 0; ks < 4; ++ks) { const f32x4 w0 = *(const f32x4*)(wp + 32 * ks), w1 = *(const f32x4*)(wp + 32 * ks + 4);
              u32x4 pk; pk.x = cvtpk(w0.x, w0.y); pk.y = cvtpk(w0.z, w0.w); pk.z = cvtpk(w1.x, w1.y); pk.w = cvtpk(w1.z, w1.w); bfr[ks] = __builtin_bit_cast(bf16x8, pk); } }
        const int p = 16 * wave + (lane & 15); const float bsp = bs[g * 128 + p];
        bf16_t* up = U + (size_t)(r0 + p) * EH + e0 + 4 * (lane >> 4);
#pragma unroll 2
        for (int et = 0; et < 24; ++et) {
            f32x4 acc = {0.f, 0.f, 0.f, 0.f};
#pragma unroll
            for (int ks = 0; ks < 4; ++ks) { const bf16x8 a = *(const LAS bf16x8*)(VT + (16 * et + (lane & 15)) * VP + 32 * ks + 8 * (lane >> 4)); acc = mfma16(a, bfr[ks], acc); }
            const u32x2 uw = *(const u32x2*)(up + 16 * et);
            u32x2 o; o.x = cvtpk(bflo(uw.x) * (acc[0] + bsp), bfhi(uw.x) * (acc[1] + bsp)); o.y = cvtpk(bflo(uw.y) * (acc[2] + bsp), bfhi(uw.y) * (acc[3] + bsp));
            *(u32x2*)(up + 16 * et) = o;
        }
        __syncthreads();
    }
}


#ifndef MK_PER_PHASE
#define MK_PER_PHASE 0
#endif
constexpr int N_STEPS = 2 + 8 * 3 + 2 * 8 + 2 * 4;
struct Args { const float* in[26]; float* out; unsigned char* ws; int ph_lo, ph_hi, mode, pad; };

__global__ void __launch_bounds__(NTHREADS, 2) mk_fwd(Args args) {
    extern __shared__ __attribute__((aligned(16))) unsigned char lds_raw[];
    LAS unsigned char* lds = (LAS unsigned char*)lds_raw;
    const int tid = threadIdx.x, lane = tid & 63, wave = __builtin_amdgcn_readfirstlane(tid >> 6);
    const int G = gridDim.x; const int bx = blockIdx.x; const int vcu = (G % 8 == 0) ? (bx % 8) * (G / 8) + bx / 8 : bx;
    const int gw = vcu * NWAVES + wave, NGW = G * NWAVES;
    LAS unsigned long long* PT = (LAS unsigned long long*)(lds + LDSCTL_OFF + 1024);
    for (int u = tid; u < (LDS_BYTES - LDSCTL_OFF) / 4; u += NTHREADS) ((LAS unsigned*)(lds + LDSCTL_OFF))[u] = 0u;
    __syncthreads();
    if (tid == 0) {
#define PT_SET(i) PT[i] = (unsigned long long)args.in[i];
        PT_SET(0) PT_SET(1) PT_SET(2) PT_SET(3) PT_SET(4) PT_SET(5) PT_SET(6) PT_SET(7) PT_SET(8) PT_SET(9) PT_SET(10) PT_SET(11) PT_SET(12) PT_SET(13)
        PT_SET(14) PT_SET(15) PT_SET(16) PT_SET(17) PT_SET(18) PT_SET(19) PT_SET(20) PT_SET(21) PT_SET(22) PT_SET(23) PT_SET(24) PT_SET(25)
#undef PT_SET
        PT[26] = (unsigned long long)args.out; PT[27] = (unsigned long long)args.ws;
    }
    __syncthreads();
    const int lo = args.ph_lo, hi = args.ph_hi;
    if (hi - lo > 1) (void)xcd_barrier_post((unsigned*)(args.ws + WS_CTL) + CW_BAR, (volatile LAS unsigned*)(lds + MISC_OFF) + 8);
#define PTRU(i) ((unsigned long long)(unsigned)__builtin_amdgcn_readfirstlane((int)(unsigned)(PT[i] & 0xffffffffull)) | ((unsigned long long)(unsigned)__builtin_amdgcn_readfirstlane((int)(unsigned)(PT[i] >> 32)) << 32))
#define INP(i) ((const float*)(const GAS float*)PTRU(i))
#define WSB ((unsigned char*)(GAS unsigned char*)PTRU(27))
#define x_in INP(0)
#define c_in INP(1)
#define ctx_in INP(2)
#define cctx_in INP(3)
#define w_ada INP(4)
#define b_ada INP(5)
#define normg INP(6)
#define X ((float*)(GAS float*)PTRU(26))
#define CTXS ((float*)(ws + WS_CTXS))
#define MOD ((float*)(ws + WS_MOD))
#define XN ((bf16_t*)(ws + WS_XN))
#define Y ((bf16_t*)(ws + WS_Y))
#define WFI ((bf16_t*)(ws + WS_WFI))
#define WFO ((bf16_t*)(ws + WS_WFO))
#define WAI ((bf16_t*)(ws + WS_WAI))
#define WAO ((bf16_t*)(ws + WS_WAO))
#define WBI ((bf16_t*)(ws + WS_WBI))
#define WBO ((bf16_t*)(ws + WS_WBO))
#define WCM ((bf16_t*)(ws + WS_WCM))

    int step = 0;
#define RUN (step >= lo && step < hi)
#define ENDSTEP do { if (RUN && step + 1 < hi) { XcdBarrier bar_; bar_.bar = (unsigned*)((GAS unsigned char*)PTRU(27) + WS_CTL) + CW_BAR; bar_.x = xb_xcc_id(); bar_.st = (volatile LAS unsigned*)(lds + MISC_OFF) + 8; xcd_barrier(bar_); } ++step; } while (0)

    if (RUN) { unsigned char* const ws = WSB;
        if (vcu < 144 && !(args.mode & 4)) adaln_unit(c_in, cctx_in, w_ada, b_ada, MOD, lds, vcu, tid, wave, lane);
        for (int i = vcu * NTHREADS + tid; i < 2 * 2048 * 16; i += G * NTHREADS) wcm_item(INP(12), INP(13), WCM, i);
        constexpr int I_FI = 16 * 88, I_FO = 44 * 16, I_AI = 16 * 64, I_AO = 32 * 16, I_BI = 16 * 96, I_BO = 48 * 16;
        constexpr int T_FI = 8 * I_FI, T_FO = T_FI + 8 * I_FO, T_AI = T_FO + 2 * I_AI, T_AO = T_AI + 2 * I_AO, T_BI = T_AO + 2 * I_BI, T_BO = T_BI + 2 * I_BO;
        unsigned* qctr = (unsigned*)(ws + WS_CTL) + 64 + 32 * (args.mode >> 8);
        LAS float* scr = (LAS float*)(lds + wave * 16640);
        volatile LAS unsigned* qslot = (volatile LAS unsigned*)(lds + MISC_OFF) + 16;
        for (;;) {
            __syncthreads();
            if (tid == 0) qslot[0] = __hip_atomic_fetch_add(qctr, 16u, __ATOMIC_RELAXED, __HIP_MEMORY_SCOPE_AGENT);
            __syncthreads();
            const int base = (int)qslot[0];
            if (base >= T_BO) break;
          for (int sub = 0; sub < 2; ++sub) {
            const int it = base + 2 * wave + sub;
            if (it >= T_BO) break;
            if (it < T_FI) { const int m = it / I_FI, r = it % I_FI; p0_transpose_item(INP(7) + (size_t)m * D * 2 * DFF, D, 2 * DFF, WFI + (size_t)m * 2 * DFF * D, 1, scr, r, lane, args.mode); }
            else if (it < T_FO) { const int q = it - T_FI, m = q / I_FO, r = q % I_FO; p0_transpose_item(INP(8) + (size_t)m * DFF * D, DFF, D, WFO + (size_t)m * D * DFF, 0, scr, r, lane, args.mode); }
            else if (it < T_AI) { const int q = it - T_FO, m = q / I_AI, r = q % I_AI; p0_transpose_item(INP(9) + (size_t)m * D * 2 * DI, D, 2 * DI, WAI + (size_t)m * 2 * DI * D, 0, scr, r, lane, args.mode); }
            else if (it < T_AO) { const int q = it - T_AI, m = q / I_AO, r = q % I_AO; p0_transpose_item(INP(17) + (size_t)m * DI * D, DI, D, WAO + (size_t)m * D * DI, 0, scr, r, lane, args.mode); }
            else if (it < T_BI) { const int q = it - T_AO, m = q / I_BI, r = q % I_BI; p0_transpose_item(INP(18) + (size_t)m * D * 2 * EH, D, 2 * EH, WBI + (size_t)m * 2 * EH * D, 0, scr, r, lane, args.mode); }
            else { const int q = it - T_BI, m = q / I_BO, r = q % I_BO; p0_transpose_item(INP(24) + (size_t)m * EH * D, EH, D, WBO + (size_t)m * D * EH, 0, scr, r, lane, args.mode); }
          }
        }
        __syncthreads();
    }
    ENDSTEP;
    if (RUN) { unsigned char* const ws = WSB; const ThinP p{1, 0, 0, 0, 0, 0.f, 1, 0, 0, 0, 1}; thin_phase(p, x_in, ctx_in, X, CTXS, Y, (const float*)(ws + WS_YCP), 0, XN, MOD, normg, gw, NGW, lane); }
    ENDSTEP;

#pragma unroll 1
    for (int sb = 0; sb < 12; ++sb) {
        const int layer = sb / 3, sub = sb % 3, li = layer >> 1;
        const int kind = (sub != 1) ? 0 : ((layer & 1) ? 2 : 1);
        const int f = sub >> 1;
        const bool cin = (kind == 0) ? ((sub == 0) ? (layer <= 2) : (layer <= 1)) : (kind == 1) ? true : (layer <= 1);
        const bool cout = (kind == 0) ? cin : (layer <= 1);
        const int Min = cin ? R : ML;
        if (kind == 0) {
            if (RUN) { unsigned char* const ws = WSB; pg8::Gemm g{XN, WFI + (size_t)(layer * 2 + f) * 2 * DFF * D, Min, 2 * DFF, D, D}; pg8::StaticOrder S; S.init(Min, 2 * DFF, G, bx);
                EpiSwiGLU E{(bf16_t*)(ws + WS_H), DFF}; pg8::gemm_phase<EpiSwiGLU, pg8::StaticOrder, PG8_ALIGN, PG8_SP2>(lds, g, S, E); }
            ENDSTEP;
        } else if (kind == 1) {
            if (RUN) { unsigned char* const ws = WSB; pg8::Gemm g{XN, WAI + (size_t)li * 2 * DI * D, R, 2 * DI, D, D}; pg8::StaticOrder S; S.init(R, 2 * DI, G, bx);
                pg8::EpiBf16<0> E{(bf16_t*)(ws + WS_XM), DI, nullptr, DI, (size_t)(WS_Z - WS_XM) / 2, 1.f}; pg8::gemm_phase<pg8::EpiBf16<0>, pg8::StaticOrder, PG8_ALIGN, PG8_SP2>(lds, g, S, E); }
            ENDSTEP;
            if (RUN) { unsigned char* const ws = WSB; phase_a2((const bf16_t*)(ws + WS_XM), (bf16_t*)(ws + WS_XC), (bf16_t*)(ws + WS_Q), (bf16_t*)(ws + WS_K), (bf16_t*)(ws + WS_VV),
                              INP(10) + (size_t)li * 9 * DI, INP(11) + (size_t)li * DI, INP(12) + (size_t)li * 3 * 512 * 16, vcu, G, wave, lane); }
            ENDSTEP;
            if (RUN) { unsigned char* const ws = WSB;
                phase_a3((bf16_t*)(ws + WS_Q), (bf16_t*)(ws + WS_K), (bf16_t*)(ws + WS_VV), (bf16_t*)(ws + WS_SRAW), (const bf16_t*)(ws + WS_XC), (const bf16_t*)(ws + WS_XM), WCM + (size_t)li * 128 * 512, INP(14) + li * 16,
                         (float*)(ws + WS_GATES), lds, vcu, G, tid, wave, lane);
            }
            ENDSTEP;
            if (RUN) { unsigned char* const ws = WSB; if (G == 256) phase_a3bc((const float*)(ws + WS_GATES), (const bf16_t*)(ws + WS_SRAW), (bf16_t*)(ws + WS_SDT), (float*)(ws + WS_TAB), (float*)(ws + WS_GM), lds, vcu, tid, wave, lane); }
            ENDSTEP;
            if (RUN) { unsigned char* const ws = WSB; if (G == 256) phase_a4((const bf16_t*)(ws + WS_Q), (const bf16_t*)(ws + WS_K), (const bf16_t*)(ws + WS_VV), (const bf16_t*)(ws + WS_SDT), (const float*)(ws + WS_TAB),
                                (bf16_t*)(ws + WS_NUMF), (bf16_t*)(ws + WS_NUMB), (float*)(ws + WS_PD), lds, vcu, tid, wave, lane); }
            ENDSTEP;
            if (RUN) { unsigned char* const ws = WSB; phase_a5((const bf16_t*)(ws + WS_NUMF), (const bf16_t*)(ws + WS_NUMB), (const float*)(ws + WS_PD), (const float*)(ws + WS_GM), (const bf16_t*)(ws + WS_XC), (const bf16_t*)(ws + WS_Z),
                              (bf16_t*)(ws + WS_G), INP(15) + (size_t)li * DI, INP(16) + (size_t)li * DI, cout ? R : ML, gw, NGW, lane); }
            ENDSTEP;
        } else {
            if (RUN) { unsigned char* const ws = WSB; pg8::Gemm g{XN, WBI + (size_t)li * 2 * EH * D, Min, 2 * EH, D, D}; pg8::StaticOrder S; S.init(Min, 2 * EH, G, bx);
                EpiGeluUV E{(bf16_t*)(ws + WS_U), (bf16_t*)(ws + WS_V), INP(19) + (size_t)li * 2 * EH, (float*)(ws + WS_VST)}; pg8::gemm_phase<EpiGeluUV, pg8::StaticOrder, PG8_ALIGN, PG8_SP2>(lds, g, S, E); }
            ENDSTEP;
            if (RUN) { unsigned char* const ws = WSB; phase_g2((bf16_t*)(ws + WS_U), (const bf16_t*)(ws + WS_V), (const float*)(ws + WS_VST), INP(20) + (size_t)li * EH, INP(21) + (size_t)li * EH,
                              INP(22) + (size_t)li * 8 * 128 * 128, INP(23) + (size_t)li * 8 * 128, Min / 128, lds, vcu, G, tid, wave, lane); }
            ENDSTEP;
        }
#define OUT_GEMM(Aexpr, Btexpr, KK, biasexpr) do { unsigned char* const ws = WSB; pg8::Gemm g{(Aexpr), (Btexpr), R, D, (KK), (KK)}; OutOrder S; S.init(cout ? (KK) : 0, G, bx); \
            EpiOut E{Y, (float*)(ws + WS_YCP), (biasexpr)}; pg8::gemm_phase<EpiOut, OutOrder, PG8_ALIGN, PG8_SP2>(lds, g, S, E); } while (0)
        if (kind == 0) { if (RUN) OUT_GEMM((const bf16_t*)(ws + WS_H), WFO + (size_t)(layer * 2 + f) * D * DFF, DFF, (const float*)nullptr); }
        else if (kind == 1) { if (RUN) OUT_GEMM((const bf16_t*)(ws + WS_G), WAO + (size_t)li * D * DI, DI, (const float*)nullptr); }
        else { if (RUN) OUT_GEMM((const bf16_t*)(ws + WS_U), WBO + (size_t)li * D * EH, EH, INP(25) + (size_t)li * D); }
#undef OUT_GEMM
        ENDSTEP;
        if (RUN) { unsigned char* const ws = WSB;
            ThinP p;
            p.first = (sb == 0) ? 1 : 0; p.has_y = 1; p.lp = layer;
            if (sub == 0) { p.gate_i = 2; p.gpost_i = 1; p.wgt = 0.5f; p.has_next = 1; p.ln = layer; p.gpre_i = 2; p.shift_i = 3; p.scale_i = 4; }
            else if (sub == 1) { p.gate_i = 5; p.gpost_i = 3; p.wgt = 1.0f; p.has_next = 1; p.ln = layer; p.gpre_i = 4; p.shift_i = 6; p.scale_i = 7; }
            else { p.gate_i = 8; p.gpost_i = 5; p.wgt = 0.5f; p.has_next = (layer < DEPTH - 1) ? 1 : 0; p.ln = (layer < DEPTH - 1) ? layer + 1 : layer; p.gpre_i = 0; p.shift_i = 0; p.scale_i = 1; }
            thin_phase(p, x_in, ctx_in, X, CTXS, Y, (const float*)(ws + WS_YCP), !cout ? -1 : (kind == 0) ? DFF / 256 : (kind == 1) ? DI / 256 : EH / 256, XN, MOD, normg, gw, NGW, lane);
        }
        ENDSTEP;
    }
#undef RUN
#undef ENDSTEP
#undef x_in
#undef c_in
#undef ctx_in
#undef cctx_in
#undef w_ada
#undef b_ada
#undef normg
#undef X
#undef CTXS
#undef MOD
#undef XN
#undef Y
#undef WFI
#undef WFO
#undef WAI
#undef WAO
#undef WBI
#undef WBO
#undef WCM
}
}

extern "C" void kernel_launch(void* const* d_in, const int* in_sizes, int n_in, void* d_out, int out_size, void* d_ws, size_t ws_size, hipStream_t stream) {
    using namespace mk;
    static int grid = 0;
    if (grid == 0) {
        if (n_in != 26 || out_size != ML * D || ws_size < WS_END) { fprintf(stderr, "kernel_launch: unexpected shapes (n_in %d, out %d, ws %zu < %zu); nothing launched\n", n_in, out_size, ws_size, (size_t)WS_END); grid = -1; return; }
        int dev = 0, cus = 0, per_cu = 0;
        if (hipGetDevice(&dev) != hipSuccess || hipDeviceGetAttribute(&cus, hipDeviceAttributeMultiprocessorCount, dev) != hipSuccess) { grid = -1; return; }
        if (hipFuncSetAttribute((const void*)mk_fwd, hipFuncAttributeMaxDynamicSharedMemorySize, LDS_BYTES) != hipSuccess) { fprintf(stderr, "kernel_launch: hipFuncSetAttribute failed\n"); grid = -1; return; }
        if (hipOccupancyMaxActiveBlocksPerMultiprocessor(&per_cu, (const void*)mk_fwd, NTHREADS, LDS_BYTES) != hipSuccess || per_cu < 1) { fprintf(stderr, "kernel_launch: occupancy query says %d\n", per_cu); }
        (void)hipGetLastError();
        grid = cus;
        if (grid != 256) { fprintf(stderr, "kernel_launch: this kernel is built for 256 CUs, found %d\n", grid); }
    }
    if (grid < 0) return;
    (void)hipMemsetAsync((char*)d_ws + WS_CTL, 0, CTL_ZERO_BYTES, stream);
    Args a{};
    for (int i = 0; i < 26; ++i) a.in[i] = (const float*)d_in[i];
    a.out = (float*)d_out; a.ws = (unsigned char*)d_ws;
#if MK_PER_PHASE
    for (int s = 0; s < N_STEPS; ++s) { a.ph_lo = s; a.ph_hi = s + 1; hipLaunchKernelGGL(mk_fwd, dim3(grid), dim3(NTHREADS), LDS_BYTES, stream, a); }
#else
    a.ph_lo = 0; a.ph_hi = N_STEPS; hipLaunchKernelGGL(mk_fwd, dim3(grid), dim3(NTHREADS), LDS_BYTES, stream, a);
#endif
#ifdef MK_PROBE_STEP
#ifdef MK_PROBE_MODE
    a.mode = MK_PROBE_MODE;
#endif
    for (int rep = 0; rep < MK_PROBE_REP; ++rep) { a.mode = (a.mode & 255) | ((rep + 1) << 8); a.ph_lo = MK_PROBE_STEP; a.ph_hi = MK_PROBE_STEP + 1; hipLaunchKernelGGL(mk_fwd, dim3(grid), dim3(NTHREADS), LDS_BYTES, stream, a); }
#endif
}
```

```cpp
#include <hip/hip_runtime.h>
#include <cstdio>
#include <cstdint>
namespace pg8 {
#define PG8_LAS __attribute__((address_space(3)))
typedef unsigned short bf16_t;
typedef short bf16x8 __attribute__((ext_vector_type(8)));
typedef float f32x4 __attribute__((ext_vector_type(4)));
typedef unsigned u32x4 __attribute__((ext_vector_type(4)));
constexpr int BM = 256, BK = 64, HALF = 128, HTB = HALF * BK * 2  , STAGE_BYTES = 8 * HTB, NXCD = 8, WGM = 8;

__host__ __device__ __forceinline__ int lds_byte(int r, int c) { const int st = (r >> 4) * 2 + (c >> 5), rr = r & 15, cc = c & 31, ob = rr * 64 + cc * 2; return st * 1024 + (ob ^ (((ob >> 9) & 1) << 5)); }
__host__ __device__ __forceinline__ void stage_rc(int b, int& R, int& C) { const int st = b / 1024, sb = b % 1024, swz = sb ^ (((sb >> 9) & 1) << 5); R = (st >> 1) * 16 + swz / 64; C = (st & 1) * 32 + (swz % 64) / 2; }
__host__ __device__ __forceinline__ int perm32(int rho) { const int n = rho >> 4, i = rho & 15; return 8 * (i >> 2) + 4 * n + (i & 3); }

struct Unit { int pm, pn, kz, nt; };
__device__ __forceinline__ void st16_wt(void* p, const __attribute__((ext_vector_type(4))) unsigned v) { asm volatile("global_store_dwordx4 %0, %1, off sc1\n\ts_nop 1" :: "v"(p), "v"(v) : "memory"); }
struct Gemm { const bf16_t* A; const bf16_t* Bt; int M, N, K, ld; };

struct StaticOrder {
    int nM, nN, nwg, G, c;
    __host__ __device__ void init(int M, int N, int G_, int c_) { nM = M / BM; nN = N / BM; nwg = nM * nN; G = G_; c = c_; }
    __host__ __device__ bool next(int i, Unit& u) const {
        const long L = (long)i * G + c; if (L >= nwg) return false;
        int wgid = (int)L; { const int q = nwg / NXCD, r = nwg % NXCD, xcd = wgid % NXCD, off = wgid / NXCD; wgid = (xcd < r ? xcd * (q + 1) : r * (q + 1) + (xcd - r) * q) + off; }
        const int nig = WGM * nN, gid = wgid / nig, fm = gid * WGM, gsz = (nM - fm) < WGM ? (nM - fm) : WGM;
        u.pm = fm + ((wgid % nig) % gsz); u.pn = (wgid % nig) / gsz; u.kz = 0; u.nt = 0; return true;
    }
    __device__ __forceinline__ void a_ready(const Unit&) const {}
    __device__ __forceinline__ void done(const Unit&) const {}
};

__device__ __forceinline__ unsigned cvt_pk_bf16(float lo, float hi) { unsigned r; asm volatile("v_cvt_pk_bf16_f32 %0, %1, %2" : "=v"(r) : "v"(lo), "v"(hi)); return r; }
typedef float f32x2 __attribute__((ext_vector_type(2)));
__device__ __forceinline__ f32x2 gelu_pk(f32x2 v) {
    const f32x2 av = __builtin_elementwise_abs(v), d = av * 0.2316418882f + 1.0f;
    f32x2 t; t.x = __builtin_amdgcn_rcpf(d.x); t.y = __builtin_amdgcn_rcpf(d.y);
    f32x2 q = t * 0.5307027145f + (-0.7265760135f); q = q * t + 0.7107068705f; q = q * t + (-0.142248368f); q = q * t + 0.127414796f; q = q * t;
    const f32x2 s = (v * v) * (-0.72134752044f);
    f32x2 e; e.x = __builtin_amdgcn_exp2f(s.x); e.y = __builtin_amdgcn_exp2f(s.y);
    const f32x2 m = v * (q * e), r = v - m;
    f32x2 o; o.x = v.x < 0.f ? m.x : r.x; o.y = v.y < 0.f ? m.y : r.y; return o;
}

template <int ACT  > struct EpiBf16 {
    static constexpr bool PERM = true, AFTER_DRAIN = false; static_assert(ACT == 0 || ACT == 1, "EpiBf16: ACT is 0 (none) or 1 (gelu_pk)");
    bf16_t* O; int ldc; const float* bias; int split_cols; size_t split_stride; float scale0;
    __device__ __forceinline__ void operator()(const f32x4 (&acc)[2][2][4][2], const Unit& u, int wr, int wc, int fr, int fq) const {
        const int row0 = u.pm * BM + wr * 64 + fr; int colt = u.pn * BM; bf16_t* base = O;
        float sc = 1.f; if (split_cols) { const int t = colt / split_cols; base += (size_t)t * split_stride; colt -= t * split_cols; if (t == 0) sc = scale0; }
        const int col0 = colt + wc * 32 + 8 * fq, bcol0 = u.pn * BM + wc * 32 + 8 * fq;
        f32x4 bv[2][2];
#pragma unroll
        for (int bj = 0; bj < 2; ++bj)
#pragma unroll
            for (int n = 0; n < 2; ++n) bv[bj][n] = bias ? *(const f32x4*)(bias + bcol0 + bj * HALF + 4 * n) : (f32x4){0.f, 0.f, 0.f, 0.f};
#pragma unroll
        for (int ai = 0; ai < 2; ++ai)
#pragma unroll
            for (int m = 0; m < 4; ++m) { bf16_t* rowp = base + (size_t)(row0 + ai * HALF + m * 16) * ldc + col0;
#pragma unroll
                for (int bj = 0; bj < 2; ++bj) { f32x4 v0 = acc[ai][bj][m][0] + bv[bj][0], v1 = acc[ai][bj][m][1] + bv[bj][1];
                    if (ACT == 1) { f32x2 a = gelu_pk((f32x2){v0[0], v0[1]}), b = gelu_pk((f32x2){v0[2], v0[3]}), c = gelu_pk((f32x2){v1[0], v1[1]}), d = gelu_pk((f32x2){v1[2], v1[3]});
                        v0 = (f32x4){a.x, a.y, b.x, b.y}; v1 = (f32x4){c.x, c.y, d.x, d.y}; }
                    v0 = v0 * sc; v1 = v1 * sc; u32x4 w; w.x = cvt_pk_bf16(v0[0], v0[1]); w.y = cvt_pk_bf16(v0[2], v0[3]); w.z = cvt_pk_bf16(v1[0], v1[1]); w.w = cvt_pk_bf16(v1[2], v1[3]);
                    *(u32x4*)(rowp + bj * HALF) = w; } }
    }
};

struct PanelStats {
    unsigned* xbuf;
    unsigned* cnt;
    unsigned* tmo;
    int ntn; float eps;
    unsigned code;
    __device__ __forceinline__ bool run(const f32x4 (&v)[2][2][4][2], const Unit& u, int wr, int wc, int fr, int fq, PG8_LAS unsigned char* lds, int wid, int lane) const {
        typedef float f32x2v __attribute__((ext_vector_type(2)));
        PG8_LAS f32x2v* P = (PG8_LAS f32x2v*)lds;
        PG8_LAS f32x2v* S = (PG8_LAS f32x2v*)(lds + 8192);
        PG8_LAS unsigned* flag = (PG8_LAS unsigned*)(lds + 8192 + 2048);
#pragma unroll
        for (int ai = 0; ai < 2; ++ai)
#pragma unroll
            for (int m = 0; m < 4; ++m) {
                float s = 0.f;
#pragma unroll
                for (int bj = 0; bj < 2; ++bj)
#pragma unroll
                    for (int n = 0; n < 2; ++n) { const f32x4 x = v[ai][bj][m][n]; s += (x[0] + x[1]) + (x[2] + x[3]); }
                s += __shfl_xor(s, 16); s += __shfl_xor(s, 32);
                const float mw = s * (1.0f / 64.0f); float q = 0.f;
#pragma unroll
                for (int bj = 0; bj < 2; ++bj)
#pragma unroll
                    for (int n = 0; n < 2; ++n) { const f32x4 d = v[ai][bj][m][n] - mw; q += (d[0] * d[0] + d[1] * d[1]) + (d[2] * d[2] + d[3] * d[3]); }
                q += __shfl_xor(q, 16); q += __shfl_xor(q, 32);
                if (fq == 0) P[(ai * HALF + wr * 64 + m * 16 + fr) * 4 + wc] = (f32x2v){mw, q};
            }
        asm volatile("s_waitcnt lgkmcnt(0)" ::: "memory"); __builtin_amdgcn_s_barrier(); asm volatile("" ::: "memory");
#if defined(BROKEN_EXCHANGE_NO_WAIT)
#warning BROKEN CONTROL BUILD: the row-statistics exchange does not wait; results are wrong by design
        if (blockIdx.x >= 64) { const long long t0_ = clock64(); while (clock64() - t0_ < 60000) __builtin_amdgcn_s_sleep(8); }
#endif
        const int row = wid * 32 + (lane & 31);
        if (lane < 32) {
            const f32x2v a = P[row * 4 + 0], b = P[row * 4 + 1], c = P[row * 4 + 2], d = P[row * 4 + 3];
            const float mt = (a.x + b.x + c.x + d.x) * 0.25f;
            const float da = a.x - mt, db = b.x - mt, dc = c.x - mt, dd = d.x - mt;
            const float m2 = (a.y + b.y) + (c.y + d.y) + 64.0f * ((da * da + db * db) + (dc * dc + dd * dd));
            unsigned long long* slot = (unsigned long long*)xbuf + ((size_t)(u.pm * BM + row) * 4 + u.pn);
            __hip_atomic_store(slot, ((unsigned long long)__float_as_uint(m2) << 32) | __float_as_uint(mt), __ATOMIC_RELAXED, __HIP_MEMORY_SCOPE_AGENT);
        }
        asm volatile("s_waitcnt vmcnt(0)" ::: "memory");
        if (lane == 0) __hip_atomic_fetch_add(cnt + 64 * u.pm, 1u, __ATOMIC_RELAXED, __HIP_MEMORY_SCOPE_AGENT);
        if (wid == 0) {
            bool dead = false; const unsigned long long t0 = __builtin_amdgcn_s_memrealtime(); const unsigned want = 8u * (unsigned)ntn;
            for (;;) {
#if defined(BROKEN_EXCHANGE_NO_WAIT)
                break;
#endif
                if ((unsigned)__builtin_amdgcn_readfirstlane(__hip_atomic_load(cnt + 64 * u.pm, __ATOMIC_RELAXED, __HIP_MEMORY_SCOPE_AGENT)) >= want) break;
                if (__builtin_amdgcn_s_memrealtime() - t0 > 2000000ull) {
                    if (lane == 0) { unsigned expect = 0u; __hip_atomic_compare_exchange_strong(tmo + 1, &expect, code | (unsigned)(u.pm & 0xff), __ATOMIC_RELAXED, __ATOMIC_RELAXED, __HIP_MEMORY_SCOPE_AGENT);
                                     __hip_atomic_store(tmo, 1u, __ATOMIC_RELAXED, __HIP_MEMORY_SCOPE_AGENT); }
                    dead = true; break; }
                __builtin_amdgcn_s_sleep(2);
            }
            __builtin_amdgcn_fence(__ATOMIC_ACQUIRE, "agent");
            if (lane == 0) flag[0] = dead ? 1u : 0u;
        }
        asm volatile("s_waitcnt vmcnt(0) lgkmcnt(0)" ::: "memory"); __builtin_amdgcn_s_barrier(); asm volatile("" ::: "memory");
        const bool bad = flag[0] != 0u;
        if (lane < 32) {
            const unsigned long long* slot = (const unsigned long long*)xbuf + (size_t)(u.pm * BM + row) * 4; float mt[4], m2[4]; float ms = 0.f;
#pragma unroll
            for (int t = 0; t < 4; ++t) { if (t < ntn) { const unsigned long long w = __hip_atomic_load(slot + t, __ATOMIC_RELAXED, __HIP_MEMORY_SCOPE_AGENT); mt[t] = __uint_as_float((unsigned)w); m2[t] = __uint_as_float((unsigned)(w >> 32)); } else { mt[t] = 0.f; m2[t] = 0.f; } ms += mt[t]; }
            const float mean = ms / (float)ntn; float q = 0.f;
#pragma unroll
            for (int t = 0; t < 4; ++t) if (t < ntn) { const float dm = mt[t] - mean; q += m2[t] + 256.0f * dm * dm; }
            S[row] = (f32x2v){mean, 1.0f / sqrtf(q / (256.0f * (float)ntn) + eps)};
        }
        asm volatile("s_waitcnt lgkmcnt(0)" ::: "memory"); __builtin_amdgcn_s_barrier(); asm volatile("" ::: "memory");
        return bad;
    }
};
struct EpiLnRes {
    static constexpr bool PERM = false, AFTER_DRAIN = true;
    const float* base; float* out; int ldc; const float* bias; PanelStats st; unsigned poison;
    __device__ __forceinline__ void fused(f32x4 (&acc)[2][2][4][2], const Unit& u, int wr, int wc, int fr, int fq, PG8_LAS unsigned char* lds, int wid, int lane) const {
        typedef float f32x2v __attribute__((ext_vector_type(2)));
        const PG8_LAS f32x2v* S = (const PG8_LAS f32x2v*)(lds + 8192);
        const int col0 = u.pn * BM + wc * 32 + 4 * fq;
#pragma unroll
        for (int bj = 0; bj < 2; ++bj)
#pragma unroll
            for (int n = 0; n < 2; ++n) { const f32x4 bv = bias ? *(const f32x4*)(bias + col0 + bj * HALF + n * 16) : (f32x4){0.f, 0.f, 0.f, 0.f};
#pragma unroll
                for (int ai = 0; ai < 2; ++ai)
#pragma unroll
                    for (int m = 0; m < 4; ++m) acc[ai][bj][m][n] += bv; }
        f32x4 pre[4][2][2];
#pragma unroll
        for (int m = 0; m < 4; ++m) { const size_t off = (size_t)(u.pm * BM + wr * 64 + m * 16 + fr) * ldc + col0;
#pragma unroll
            for (int bj = 0; bj < 2; ++bj)
#pragma unroll
                for (int n = 0; n < 2; ++n) pre[m][bj][n] = *(const f32x4*)(base + off + bj * HALF + n * 16); }
        const bool bad = st.run(acc, u, wr, wc, fr, fq, lds, wid, lane) || poison != 0u;
        const float qnan = __builtin_nanf("");
#pragma unroll
        for (int ai = 0; ai < 2; ++ai)
#pragma unroll
            for (int m = 0; m < 4; ++m) { const int r = ai * HALF + wr * 64 + m * 16 + fr; const f32x2v sr = S[r]; const size_t off = (size_t)(u.pm * BM + r) * ldc + col0;
#pragma unroll
                for (int bj = 0; bj < 2; ++bj)
#pragma unroll
                    for (int n = 0; n < 2; ++n) { const f32x4 bs = ai == 0 ? pre[m][bj][n] : *(const f32x4*)(base + off + bj * HALF + n * 16); f32x4 o = bs + (acc[ai][bj][m][n] - sr.x) * sr.y;
                        if (bad) o = (f32x4){qnan, qnan, qnan, qnan}; *(f32x4*)(out + off + bj * HALF + n * 16) = o; }
                if (m & 1) asm volatile("" ::: "memory"); }
    }
};
struct EpiLnResLn {
    static constexpr bool PERM = false, AFTER_DRAIN = true;
    const float* base; float* out; bf16_t* xn; int ldc; const float* bias; PanelStats st1, st2; unsigned poison;
    __device__ __forceinline__ void fused(f32x4 (&acc)[2][2][4][2], const Unit& u, int wr, int wc, int fr, int fq, PG8_LAS unsigned char* lds, int wid, int lane) const {
        typedef float f32x2v __attribute__((ext_vector_type(2))); typedef unsigned u32x2v __attribute__((ext_vector_type(2)));
        const PG8_LAS f32x2v* S = (const PG8_LAS f32x2v*)(lds + 8192);
        const int col0 = u.pn * BM + wc * 32 + 4 * fq;
#pragma unroll
        for (int bj = 0; bj < 2; ++bj)
#pragma unroll
            for (int n = 0; n < 2; ++n) { const f32x4 bv = bias ? *(const f32x4*)(bias + col0 + bj * HALF + n * 16) : (f32x4){0.f, 0.f, 0.f, 0.f};
#pragma unroll
                for (int ai = 0; ai < 2; ++ai)
#pragma unroll
                    for (int m = 0; m < 4; ++m) acc[ai][bj][m][n] += bv; }
        bool bad = st1.run(acc, u, wr, wc, fr, fq, lds, wid, lane) || poison != 0u;
        const float qnan = __builtin_nanf("");
#pragma unroll
        for (int ai = 0; ai < 2; ++ai)
#pragma unroll
            for (int m = 0; m < 4; ++m) { const int r = ai * HALF + wr * 64 + m * 16 + fr; const f32x2v sr = S[r]; const size_t off = (size_t)(u.pm * BM + r) * ldc + col0;
#pragma unroll
                for (int bj = 0; bj < 2; ++bj)
#pragma unroll
                    for (int n = 0; n < 2; ++n) { const f32x4 bs = *(const f32x4*)(base + off + bj * HALF + n * 16); acc[ai][bj][m][n] = bs + (acc[ai][bj][m][n] - sr.x) * sr.y; }
                asm volatile("" : "+v"(acc[ai][0][m][0]), "+v"(acc[ai][0][m][1]), "+v"(acc[ai][1][m][0]), "+v"(acc[ai][1][m][1]));
                if (m & 1) asm volatile("" ::: "memory"); }
        const bool bad1 = bad;
        bad = st2.run(acc, u, wr, wc, fr, fq, lds, wid, lane) || bad;
#pragma unroll
        for (int ai = 0; ai < 2; ++ai)
#pragma unroll
            for (int m = 0; m < 4; ++m) { const int r = ai * HALF + wr * 64 + m * 16 + fr; const f32x2v sr = S[r]; const size_t off = (size_t)(u.pm * BM + r) * ldc + col0;
#pragma unroll
                for (int bj = 0; bj < 2; ++bj)
#pragma unroll
                    for (int n = 0; n < 2; ++n) { const f32x4 x1 = acc[ai][bj][m][n]; *(f32x4*)(out + off + bj * HALF + n * 16) = bad1 ? (f32x4){qnan, qnan, qnan, qnan} : x1;
                        const f32x4 o = (x1 - sr.x) * sr.y; u32x2v w; w.x = cvt_pk_bf16(o[0], o[1]); w.y = cvt_pk_bf16(o[2], o[3]);
                        if (bad) { w.x = 0x7fc07fc0u; w.y = 0x7fc07fc0u; } *(u32x2v*)(xn + off + bj * HALF + n * 16) = w; }
                asm volatile("" ::: "memory"); }
    }
};

template <class Epi, class Sched, bool ALIGN_EPI = false, bool SP2 = false>
__device__ __forceinline__ void gemm_phase(PG8_LAS unsigned char* lds, const Gemm g, const Sched& S, const Epi& E) {
    int tid_ = threadIdx.x; asm volatile("" : "+v"(tid_));
    const int tid = tid_, wid = __builtin_amdgcn_readfirstlane(tid >> 6), lane = tid & 63, wr = wid >> 2, wc = wid & 3, fr = lane & 15, fq = lane >> 4;
    const int K = g.ld, nt = g.K / BK; const size_t kzstep = 512;
    unsigned voffA[2], voffB[2];
#pragma unroll
    for (int i = 0; i < 2; ++i) { int R, C; stage_rc(tid * 16 + i * 8192, R, C); const int Rb = Epi::PERM ? ((R & ~31) + perm32(R & 31)) : R;
        voffA[i] = (unsigned)(R * K + C) * 2u; voffB[i] = (unsigned)(Rb * K + C) * 2u; }
    const size_t kstep = (size_t)(BK * 2);
    const size_t hstep = (size_t)HALF * K * 2;
    const size_t tstep = 2 * hstep;
    const unsigned ldsw = (unsigned)wid * 1024u;
    const int aoff = lds_byte(wr * 64 + fr, fq * 8), boff = lds_byte(wc * 32 + fr, fq * 8);
#define PG8_SA(b, h) (((b) * 2 + (h)) * HTB)
#define PG8_SB(b, h) ((4 + (b) * 2 + (h)) * HTB)
#define PG8_STAGE(bufoff, gbase, voff) do { _Pragma("unroll") for (int _i = 0; _i < 2; ++_i) \
        __builtin_amdgcn_global_load_lds((const unsigned*)((const char*)(gbase) + (voff)[_i]), (PG8_LAS unsigned*)(lds + (bufoff) + ldsw + _i * 8192), 16, 0, 0); } while (0)
#define PG8_LDA(dst, b, h) do { _Pragma("unroll") for (int m = 0; m < 4; ++m) _Pragma("unroll") for (int k = 0; k < 2; ++k) dst[m][k] = *(const PG8_LAS bf16x8*)(lds + PG8_SA(b, h) + aoff + m * 2048 + k * 1024); } while (0)
#define PG8_LDB(dst, b, h) do { _Pragma("unroll") for (int n = 0; n < 2; ++n) _Pragma("unroll") for (int k = 0; k < 2; ++k) dst[n][k] = *(const PG8_LAS bf16x8*)(lds + PG8_SB(b, h) + boff + n * 2048 + k * 1024); } while (0)
#define PG8_MMA(ai, bj, At, Bt) do { __builtin_amdgcn_s_setprio(1); _Pragma("unroll") for (int m = 0; m < 4; ++m) _Pragma("unroll") for (int n = 0; n < 2; ++n) _Pragma("unroll") for (int k = 0; k < 2; ++k) \
        acc[ai][bj][m][n] = __builtin_amdgcn_mfma_f32_16x16x32_bf16(Bt[n][k], At[m][k], acc[ai][bj][m][n], 0, 0, 0); __builtin_amdgcn_s_setprio(0); } while (0)
#define PG8_WAIT_V(n) asm volatile("s_waitcnt vmcnt(" #n ")" ::: "memory")
#define PG8_WAIT_L(n) asm volatile("s_waitcnt lgkmcnt(" #n ")" ::: "memory")
#define PG8_BAR __builtin_amdgcn_s_barrier()
#define PG8_SCHED __builtin_amdgcn_sched_barrier(0)
    Unit cur, nxt; int ui = 0;
    if (!S.next(0, cur)) return;
    f32x4 acc[2][2][4][2];
#pragma unroll
    for (int a = 0; a < 2; ++a)
#pragma unroll
        for (int b = 0; b < 2; ++b)
#pragma unroll
            for (int m = 0; m < 4; ++m)
#pragma unroll
                for (int n = 0; n < 2; ++n) acc[a][b][m][n] = (f32x4){0.f, 0.f, 0.f, 0.f};
    bf16x8 At[4][2], B0[2][2], B1[2][2];
    const char* cA = (const char*)g.A + (size_t)cur.pm * tstep + (size_t)cur.kz * kzstep; const char* cB = (const char*)g.Bt + (size_t)cur.pn * tstep + (size_t)cur.kz * kzstep;
    S.a_ready(cur);
    if constexpr (SP2) {
        PG8_STAGE(PG8_SB(0, 0), cB, voffB); PG8_STAGE(PG8_SB(0, 1), cB + hstep, voffB); PG8_STAGE(PG8_SA(0, 0), cA, voffA); PG8_STAGE(PG8_SA(0, 1), cA + hstep, voffA);
        if (wr == 1) PG8_BAR;
        PG8_WAIT_V(2); PG8_BAR;
        PG8_STAGE(PG8_SB(1, 0), cB + kstep, voffB); PG8_STAGE(PG8_SA(1, 0), cA + kstep, voffA); PG8_STAGE(PG8_SB(1, 1), cB + hstep + kstep, voffB);
        PG8_WAIT_V(6); PG8_BAR;
    } else {
        PG8_STAGE(PG8_SB(0, 0), cB, voffB); PG8_STAGE(PG8_SA(0, 0), cA, voffA); PG8_STAGE(PG8_SB(0, 1), cB + hstep, voffB); PG8_STAGE(PG8_SA(0, 1), cA + hstep, voffA);
        if (wr == 1) PG8_BAR;
        PG8_WAIT_V(4); PG8_BAR;
        PG8_STAGE(PG8_SB(1, 0), cB + kstep, voffB); PG8_STAGE(PG8_SA(1, 0), cA + kstep, voffA); PG8_STAGE(PG8_SB(1, 1), cB + hstep + kstep, voffB);
        PG8_WAIT_V(6); PG8_BAR;
    }
    for (;;) {
        const bool has_next = S.next(ui + 1, nxt);
        const char* nA = has_next ? (const char*)g.A + (size_t)nxt.pm * tstep + (size_t)nxt.kz * kzstep : cA; const char* nB = has_next ? (const char*)g.Bt + (size_t)nxt.pn * tstep + (size_t)nxt.kz * kzstep : cB;
        const int ntu = cur.nt ? cur.nt : nt;
        for (int t = 0; t < ntu; t += 2) {
            const bool last = (t == ntu - 2);
            const char* a1 = cA + (size_t)(t + 1) * kstep;
            const char* a2 = last ? nA : cA + (size_t)(t + 2) * kstep; const char* b2 = last ? nB : cB + (size_t)(t + 2) * kstep;
            const char* a3 = a2 + kstep; const char* b3 = b2 + kstep;
            if (last && has_next) S.a_ready(nxt);
            if constexpr (SP2) {
            PG8_LDB(B0, 0, 0); PG8_LDB(B1, 0, 1); PG8_SCHED; PG8_LDA(At, 0, 0); PG8_STAGE(PG8_SA(1, 1), a1 + hstep, voffA);
            PG8_WAIT_V(8); PG8_WAIT_L(0); PG8_BAR; PG8_MMA(0, 0, At, B0); PG8_MMA(0, 1, At, B1); PG8_BAR; PG8_SCHED;
            PG8_LDA(At, 0, 1); PG8_STAGE(PG8_SB(0, 0), b2, voffB); PG8_STAGE(PG8_SB(0, 1), b2 + hstep, voffB); PG8_STAGE(PG8_SA(0, 0), a2, voffA);
            PG8_WAIT_V(8); PG8_WAIT_L(0); PG8_BAR; PG8_MMA(1, 0, At, B0); PG8_MMA(1, 1, At, B1); PG8_BAR; PG8_SCHED;
            PG8_LDB(B0, 1, 0); PG8_LDB(B1, 1, 1); PG8_SCHED; PG8_LDA(At, 1, 0); PG8_STAGE(PG8_SA(0, 1), a2 + hstep, voffA);
            PG8_WAIT_V(8); PG8_WAIT_L(0); PG8_BAR; PG8_MMA(0, 0, At, B0); PG8_MMA(0, 1, At, B1); PG8_BAR; PG8_SCHED;
            PG8_LDA(At, 1, 1); PG8_STAGE(PG8_SB(1, 0), b3, voffB); PG8_STAGE(PG8_SB(1, 1), b3 + hstep, voffB); PG8_STAGE(PG8_SA(1, 0), a3, voffA);
            PG8_WAIT_V(8); PG8_WAIT_L(0); PG8_BAR; PG8_MMA(1, 0, At, B0); PG8_MMA(1, 1, At, B1); PG8_BAR; PG8_SCHED;
            } else {
            PG8_LDB(B0, 0, 0); PG8_SCHED; PG8_LDA(At, 0, 0); PG8_STAGE(PG8_SA(1, 1), a1 + hstep, voffA);
            PG8_WAIT_L(8); PG8_BAR; PG8_WAIT_L(0); PG8_MMA(0, 0, At, B0); PG8_BAR; PG8_SCHED;
            PG8_LDB(B1, 0, 1); PG8_STAGE(PG8_SB(0, 0), b2, voffB);
            PG8_BAR; PG8_WAIT_L(0); PG8_MMA(0, 1, At, B1); PG8_BAR;
            PG8_LDA(At, 0, 1); PG8_STAGE(PG8_SA(0, 0), a2, voffA);
            PG8_BAR; PG8_WAIT_L(0); PG8_MMA(1, 0, At, B0); PG8_BAR; PG8_SCHED;
            PG8_STAGE(PG8_SB(0, 1), b2 + hstep, voffB);
            PG8_WAIT_V(6); PG8_BAR; PG8_MMA(1, 1, At, B1); PG8_BAR;
            PG8_LDB(B0, 1, 0); PG8_SCHED; PG8_LDA(At, 1, 0); PG8_STAGE(PG8_SA(0, 1), a2 + hstep, voffA);
            PG8_WAIT_L(8); PG8_BAR; PG8_WAIT_L(0); PG8_MMA(0, 0, At, B0); PG8_BAR; PG8_SCHED;
            PG8_LDB(B1, 1, 1); PG8_STAGE(PG8_SB(1, 0), b3, voffB);
            PG8_BAR; PG8_WAIT_L(0); PG8_MMA(0, 1, At, B1); PG8_BAR;
            PG8_LDA(At, 1, 1); PG8_STAGE(PG8_SA(1, 0), a3, voffA);
            PG8_BAR; PG8_WAIT_L(0); PG8_MMA(1, 0, At, B0); PG8_BAR; PG8_SCHED;
            PG8_STAGE(PG8_SB(1, 1), b3 + hstep, voffB);
            PG8_WAIT_V(6); PG8_BAR; PG8_MMA(1, 1, At, B1); PG8_BAR;
            }
        }
        if constexpr (ALIGN_EPI) { if (wr == 0) PG8_BAR; }
        if constexpr (!Epi::AFTER_DRAIN) { E(acc, cur, wr, wc, fr, fq); S.done(cur); }
        if (!has_next) break;
#pragma unroll
        for (int a = 0; a < 2; ++a)
#pragma unroll
            for (int b = 0; b < 2; ++b)
#pragma unroll
                for (int m = 0; m < 4; ++m)
#pragma unroll
                    for (int n = 0; n < 2; ++n) acc[a][b][m][n] = (f32x4){0.f, 0.f, 0.f, 0.f};
        cur = nxt; cA = nA; cB = nB; ++ui;
        if constexpr (ALIGN_EPI) { if (wr == 1) PG8_BAR; }
    }
    PG8_WAIT_V(0);
    if constexpr (!ALIGN_EPI) { if (wr == 0) PG8_BAR; }
    PG8_BAR;
    if constexpr (Epi::AFTER_DRAIN) { E.fused(acc, cur, wr, wc, fr, fq, lds, wid, lane); S.done(cur); }
#undef PG8_SA
#undef PG8_SB
#undef PG8_STAGE
#undef PG8_LDA
#undef PG8_LDB
#undef PG8_MMA
#undef PG8_WAIT_V
#undef PG8_WAIT_L
#undef PG8_BAR
#undef PG8_SCHED
}
}


#ifndef PG8_SP2
#define PG8_SP2 true
#endif
#ifndef PG8_ALIGN
#define PG8_ALIGN true
#endif

#define GAS __attribute__((address_space(1)))
#define LAS __attribute__((address_space(3)))

namespace mk {
using pg8::bf16_t; using pg8::bf16x8; using pg8::f32x4; using pg8::u32x4; using pg8::Unit;
typedef float f32x2 __attribute__((ext_vector_type(2)));
typedef unsigned u32x2 __attribute__((ext_vector_type(2)));
typedef __bf16 bf16x2_t __attribute__((ext_vector_type(2)));

constexpr int NWAVES = 8, NTHREADS = 512;
constexpr int D = 1024, BATCH = 2, SEQ = 8192, CTXL = 256, DEPTH = 4, DFF = 2816, DI = 2048, NH = 4, DH = 512, EH = 3072;
constexpr int ML = BATCH * SEQ, MC = BATCH * CTXL, R = ML + MC;
constexpr int NPOS = CTXL + SEQ, NCHUNK = NPOS / 64;
constexpr float EPS = 1e-6f;

constexpr size_t MiB = 1u << 20;
constexpr size_t WS_CTL = 0, CTL_ZERO_BYTES = 1 * MiB;
constexpr size_t WS_MOD = 1 * MiB;
constexpr size_t WS_CTXS = 2 * MiB;
constexpr size_t WS_GATES = 4 * MiB;
constexpr size_t WS_WCM = 5 * MiB + 256 * 1024;
constexpr size_t WS_GB = 6 * MiB, WS_GM = WS_GB + 640 * 1024, WS_GI = WS_GM + 640 * 1024;
constexpr size_t WS_WFI = 8 * MiB, WS_WFO = 96 * MiB, WS_WAI = 140 * MiB, WS_WAO = 156 * MiB, WS_WBI = 164 * MiB, WS_WBO = 188 * MiB;
constexpr size_t WS_XN = 200 * MiB, WS_Y = 233 * MiB, WS_NUMB = 200 * MiB;
constexpr size_t WS_T0 = 266 * MiB;
constexpr size_t WS_H = WS_T0;
constexpr size_t WS_U = WS_T0, WS_V = 365 * MiB, WS_VST = 464 * MiB;
constexpr size_t WS_XM = WS_T0, WS_NUMF = WS_T0, WS_Z = 332 * MiB, WS_XC = 398 * MiB, WS_Q = 464 * MiB, WS_G = WS_Q, WS_K = 530 * MiB, WS_VV = 596 * MiB;
constexpr size_t WS_YCP = 400 * MiB;
constexpr size_t WS_XALT = 430 * MiB;
constexpr size_t WS_SRAW = 662 * MiB, WS_PD = 671 * MiB, WS_SDT = 680 * MiB, WS_TAB = 698 * MiB, WS_END = 701 * MiB;
constexpr int CW_BAR = 4096;

constexpr int RING_BYTES = 139264, LDSCTL_OFF = RING_BYTES, MISC_OFF = LDSCTL_OFF + 320, LDS_BYTES = 155648;

__device__ __forceinline__ unsigned cvtpk(float lo, float hi) { f32x2 v = {lo, hi}; bf16x2_t b = __builtin_convertvector(v, bf16x2_t); return __builtin_bit_cast(unsigned, b); }
__device__ __forceinline__ float bflo(unsigned u) { return __builtin_bit_cast(float, u << 16); }
__device__ __forceinline__ float bfhi(unsigned u) { return __builtin_bit_cast(float, u & 0xffff0000u); }
__device__ __forceinline__ float bf2f(bf16_t u) { return __builtin_bit_cast(float, (unsigned)u << 16); }
__device__ __forceinline__ bf16_t f2bf(float f) { return (bf16_t)(cvtpk(f, 0.f) & 0xffffu); }
template <int CTRL, int ROWMASK> __device__ __forceinline__ float dpp_get(float ident, float v) {
    return __builtin_bit_cast(float, __builtin_amdgcn_update_dpp(__builtin_bit_cast(int, ident), __builtin_bit_cast(int, v), CTRL, ROWMASK, 0xf, false)); }
__device__ __forceinline__ float wave_sum(float v) {
    v += dpp_get<0x111, 0xf>(0.f, v); v += dpp_get<0x112, 0xf>(0.f, v); v += dpp_get<0x114, 0xf>(0.f, v); v += dpp_get<0x118, 0xf>(0.f, v);
    v += dpp_get<0x142, 0xa>(0.f, v); v += dpp_get<0x143, 0xc>(0.f, v);
    return __builtin_bit_cast(float, __builtin_amdgcn_readlane(__builtin_bit_cast(int, v), 63));
}
template <int N> __device__ __forceinline__ float dpp_row_shr_add(float v) { const int t = __builtin_amdgcn_update_dpp(0, __builtin_bit_cast(int, v), 0x110 + N, 0xf, 0xf, true); return v + __builtin_bit_cast(float, t); }
__device__ __forceinline__ float rowsum8(float v) { v = dpp_row_shr_add<1>(v); v = dpp_row_shr_add<2>(v); v = dpp_row_shr_add<4>(v); return v; }
__device__ __forceinline__ float rowsum16(float v) { v = rowsum8(v); v = dpp_row_shr_add<8>(v); return v; }
__device__ __forceinline__ float silu_f(float v) { return v * __builtin_amdgcn_rcpf(1.0f + __expf(-v)); }
__device__ __forceinline__ f32x4 mfma16(bf16x8 a, bf16x8 b, f32x4 c) { return __builtin_amdgcn_mfma_f32_16x16x32_bf16(a, b, c, 0, 0, 0); }
#define LDS_WAIT() asm volatile("s_waitcnt lgkmcnt(0)" ::: "memory")
#define VM_WAIT() asm volatile("s_waitcnt vmcnt(0)" ::: "memory")

#define XB_TMO      128
#define XB_XCNT(j)  (256  + 64 * (j))
#define XB_XSUB(j)  (1280 + 64 * (j))
#define XB_XGEN(j)  (2304 + 64 * (j))
#define XB_TOP      3328
#define XB_TOPGEN   3392
#define XCD_BAR_WORDS 3456
#define XB_SPIN_CAP (1u << 18)
__device__ __forceinline__ unsigned xb_ld(unsigned* p)              { return __hip_atomic_load(p, __ATOMIC_RELAXED, __HIP_MEMORY_SCOPE_AGENT); }
__device__ __forceinline__ unsigned xb_add(unsigned* p, unsigned v) { return __hip_atomic_fetch_add(p, v, __ATOMIC_RELAXED, __HIP_MEMORY_SCOPE_AGENT); }
__device__ __forceinline__ unsigned xb_xcc_id() { return (unsigned)__builtin_amdgcn_s_getreg((3 << 11) | 20) & 0xFu; }
#define XB_SPIN(cond, bar) do { unsigned _sp = 0; while (cond) { __builtin_amdgcn_s_sleep(1); \
    if ((++_sp & 255u) == 0u) { if (xb_ld(&(bar)[XB_TMO])) break; if (_sp > XB_SPIN_CAP) { atomicAdd(&(bar)[XB_TMO], 1u); break; } } } } while (0)
struct XcdBarrier { unsigned* bar; unsigned x; volatile LAS unsigned* st; };
__device__ __forceinline__ XcdBarrier xcd_barrier_post(unsigned* bar, volatile LAS unsigned* st) {
    XcdBarrier b; b.bar = bar; b.x = xb_xcc_id(); b.st = st;
    if (threadIdx.x == 0) (void)xb_add(&bar[XB_XCNT(b.x)], 1u);
    return b;
}
__device__ __forceinline__ void xcd_barrier_complete(unsigned* bar, unsigned x, unsigned& nloc, unsigned& nx) {
    const unsigned G = gridDim.x * gridDim.y * gridDim.z;
    unsigned sum, cnt, mine, sp = 0u;
    for (;;) {
        sum = 0u; cnt = 0u; mine = 0u;
#pragma unroll
        for (unsigned j = 0; j < 16; ++j) { const unsigned c = xb_ld(&bar[XB_XCNT(j)]); sum += c; cnt += (c > 0u) ? 1u : 0u; mine = (j == x) ? c : mine; }
        if (sum == G) break;
        __builtin_amdgcn_s_sleep(1);
        if ((++sp & 255u) == 0u) { if (xb_ld(&bar[XB_TMO])) break; if (sp > XB_SPIN_CAP) { atomicAdd(&bar[XB_TMO], 1u); break; } }
    }
    nloc = mine > 0u ? mine : 1u; nx = cnt > 0u ? cnt : 1u;
}
__device__ __forceinline__ void xcd_barrier(const XcdBarrier& b) {
    asm volatile("s_waitcnt vmcnt(0)" ::: "memory");
    __syncthreads();
    if (threadIdx.x == 0) {
        unsigned* bar = b.bar;
        __builtin_amdgcn_s_waitcnt(0);
        unsigned nloc = b.st[0], nx = b.st[1];
        if (nloc == 0u) { xcd_barrier_complete(bar, b.x, nloc, nx); b.st[0] = nloc; b.st[1] = nx; }
        asm volatile("buffer_inv sc1" ::: "memory");
        const unsigned old = xb_add(&bar[XB_XSUB(b.x)], 1u);
        const unsigned gen = old / nloc;
        if (old + 1u == (gen + 1u) * nloc) {
            __builtin_amdgcn_fence(__ATOMIC_RELEASE, "agent");
            asm volatile("s_waitcnt vmcnt(0)" ::: "memory");
            asm volatile("buffer_inv sc1" ::: "memory");
            (void)xb_add(&bar[XB_TOP], 1u);
        }
        XB_SPIN(xb_ld(&bar[XB_TOP]) < (gen + 1u) * nx, bar);
        asm volatile("s_waitcnt vmcnt(0)" ::: "memory");
    }
    __syncthreads();
}

struct EpiSwiGLU {
    static constexpr bool PERM = true, AFTER_DRAIN = false;
    bf16_t* O; int ldc;
    __device__ __forceinline__ void operator()(const f32x4 (&acc)[2][2][4][2], const Unit& u, int wr, int wc, int fr, int fq) const {
        const int row0 = u.pm * 256 + wr * 64 + fr, col0 = u.pn * 128 + wc * 32 + 8 * fq;
#pragma unroll
        for (int ai = 0; ai < 2; ++ai)
#pragma unroll
            for (int m = 0; m < 4; ++m) {
                bf16_t* rowp = O + (size_t)(row0 + ai * 128 + m * 16) * ldc + col0;
                const f32x4 g0 = acc[ai][0][m][0], g1 = acc[ai][0][m][1], u0 = acc[ai][1][m][0], u1 = acc[ai][1][m][1];
                u32x4 w;
                w.x = cvtpk(silu_f(g0[0]) * u0[0], silu_f(g0[1]) * u0[1]); w.y = cvtpk(silu_f(g0[2]) * u0[2], silu_f(g0[3]) * u0[3]);
                w.z = cvtpk(silu_f(g1[0]) * u1[0], silu_f(g1[1]) * u1[1]); w.w = cvtpk(silu_f(g1[2]) * u1[2], silu_f(g1[3]) * u1[3]);
                *(u32x4*)rowp = w;
            }
    }
};
struct EpiGeluUV {
    static constexpr bool PERM = true, AFTER_DRAIN = false;
    bf16_t* U; bf16_t* V; const float* bias; float* vst;
    __device__ __forceinline__ void operator()(const f32x4 (&acc)[2][2][4][2], const Unit& u, int wr, int wc, int fr, int fq) const {
        const int row0 = u.pm * 256 + wr * 64 + fr;
        const int t = (u.pn >= 12) ? 1 : 0;
        bf16_t* base = t ? V : U;
        const int col0 = (u.pn - 12 * t) * 256 + wc * 32 + 8 * fq, bcol0 = u.pn * 256 + wc * 32 + 8 * fq;
        f32x4 bv[2][2];
#pragma unroll
        for (int bj = 0; bj < 2; ++bj)
#pragma unroll
            for (int n = 0; n < 2; ++n) bv[bj][n] = *(const f32x4*)(bias + bcol0 + bj * 128 + 4 * n);
#pragma unroll
        for (int ai = 0; ai < 2; ++ai)
#pragma unroll
            for (int m = 0; m < 4; ++m) {
                const int row = row0 + ai * 128 + m * 16;
                bf16_t* rowp = base + (size_t)row * EH + col0;
                float s = 0.f, q = 0.f;
#pragma unroll
                for (int bj = 0; bj < 2; ++bj) {
                    f32x4 v0 = acc[ai][bj][m][0] + bv[bj][0], v1 = acc[ai][bj][m][1] + bv[bj][1];
                    pg8::f32x2 a = pg8::gelu_pk((pg8::f32x2){v0[0], v0[1]}), b = pg8::gelu_pk((pg8::f32x2){v0[2], v0[3]}), c = pg8::gelu_pk((pg8::f32x2){v1[0], v1[1]}), d = pg8::gelu_pk((pg8::f32x2){v1[2], v1[3]});
                    u32x4 w; w.x = cvtpk(a.x, a.y); w.y = cvtpk(b.x, b.y); w.z = cvtpk(c.x, c.y); w.w = cvtpk(d.x, d.y);
                    *(u32x4*)(rowp + bj * 128) = w;
                    s += (a.x + a.y) + (b.x + b.y) + (c.x + c.y) + (d.x + d.y);
                    q += (a.x * a.x + a.y * a.y) + (b.x * b.x + b.y * b.y) + (c.x * c.x + c.y * c.y) + (d.x * d.x + d.y * d.y);
                }
                if (t) {
                    s += __shfl_xor(s, 16); s += __shfl_xor(s, 32); q += __shfl_xor(q, 16); q += __shfl_xor(q, 32);
                    if (fq == 0) *(f32x2*)(vst + ((size_t)row * 48 + (u.pn - 12) * 4 + wc) * 2) = (f32x2){s, q};
                }
            }
    }
};

struct OutOrder {
    pg8::StaticOrder so; int nks, G, c;
    __host__ __device__ void init(int K, int G_, int c_) { so.init(ML, D, G_, c_); nks = K / 256; G = G_; c = c_; }
    __device__ bool next(int i, Unit& u) const {
        if (i == 0) return so.next(0, u);
        const int L = (i - 1) * G + ((c + 128) % G); if (L >= 8 * nks) return false;
        u.kz = L >> 3; u.pm = 64 + ((L >> 2) & 1); u.pn = L & 3; u.nt = 4; return true; }
    __device__ __forceinline__ void a_ready(const Unit&) const {}
    __device__ __forceinline__ void done(const Unit&) const {}
};
struct EpiOut {
    static constexpr bool PERM = true, AFTER_DRAIN = false;
    bf16_t* Yo; float* P; const float* bias;
    __device__ __forceinline__ void operator()(const f32x4 (&acc)[2][2][4][2], const Unit& u, int wr, int wc, int fr, int fq) const {
        const int col0 = u.pn * 256 + wc * 32 + 8 * fq;
        const bool addb = (bias != nullptr) && (u.kz == 0);
        f32x4 bv[2][2];
#pragma unroll
        for (int bj = 0; bj < 2; ++bj)
#pragma unroll
            for (int n = 0; n < 2; ++n) bv[bj][n] = addb ? *(const f32x4*)(bias + col0 + bj * 128 + 4 * n) : (f32x4){0.f, 0.f, 0.f, 0.f};
        const bool lat = u.pm < 64;
        const int row0 = (lat ? u.pm : u.pm - 64) * 256 + wr * 64 + fr;
        unsigned char* base = lat ? (unsigned char*)Yo : (unsigned char*)(P + (size_t)u.kz * MC * D);
        const int sh = lat ? 1 : 2;
#pragma unroll
        for (int ai = 0; ai < 2; ++ai)
#pragma unroll
            for (int m = 0; m < 4; ++m) { unsigned char* rowp = base + (((size_t)(row0 + ai * 128 + m * 16) * D + col0) << sh);
#pragma unroll
                for (int bj = 0; bj < 2; ++bj) { const f32x4 v0 = acc[ai][bj][m][0] + bv[bj][0], v1 = acc[ai][bj][m][1] + bv[bj][1];
                    if (lat) { u32x4 w; w.x = cvtpk(v0[0], v0[1]); w.y = cvtpk(v0[2], v0[3]); w.z = cvtpk(v1[0], v1[1]); w.w = cvtpk(v1[2], v1[3]); *(u32x4*)(rowp + bj * 256) = w; }
                    else { *(f32x4*)(rowp + bj * 512) = v0; *(f32x4*)(rowp + bj * 512 + 16) = v1; } }
                asm volatile("" ::: "memory"); }
    }
};

__device__ __forceinline__ void p0_transpose_item(const float* W, int K, int N, bf16_t* WT, int mode, LAS float* scr, int item, int lane, int pmode) {
    const int nblk = N / 64, kb = item / nblk, nb = item % nblk, k0 = 64 * kb, n0 = 64 * nb;
    int orow0 = n0;
    if (mode) { const int hh = (n0 < DFF) ? n0 : n0 - DFF; orow0 = (hh >> 7) * 256 + (hh & 127) + ((n0 < DFF) ? 0 : 128); }
    const int kr = lane >> 4, nc = 4 * (lane & 15);
    const float* wp = W + (size_t)(k0 + kr) * N + n0 + nc;
    f32x4 v[16];
#pragma unroll
    for (int i = 0; i < 16; ++i) v[i] = (pmode & 2) ? (f32x4){1.f, 2.f, 3.f, 4.f} : __builtin_nontemporal_load((const f32x4*)(wp + (size_t)(4 * i) * N));
#pragma unroll
    for (int i = 0; i < 16; ++i) { LAS float* d = scr + (4 * i + kr) * 65 + nc; d[0] = v[i].x; d[1] = v[i].y; d[2] = v[i].z; d[3] = v[i].w; }
    LDS_WAIT(); asm volatile("" ::: "memory");
    const int kc = lane & 7;
#pragma unroll
    for (int j = 0; j < 8; ++j) { const int n = (lane >> 3) + 8 * j; const LAS float* sp = scr + (8 * kc) * 65 + n;
        u32x4 o; o.x = cvtpk(sp[0 * 65], sp[1 * 65]); o.y = cvtpk(sp[2 * 65], sp[3 * 65]); o.z = cvtpk(sp[4 * 65], sp[5 * 65]); o.w = cvtpk(sp[6 * 65], sp[7 * 65]);
        if (!(pmode & 1)) *(u32x4*)(WT + (size_t)(orow0 + n) * K + k0 + 8 * kc) = o; }
    LDS_WAIT(); asm volatile("" ::: "memory");
}
__device__ __forceinline__ void adaln_unit(const float* c, const float* cctx, const float* w_ada, const float* b_ada, float* MOD, LAS unsigned char* lds, int unit, int tid, int wave, int lane) {
    asm volatile("" : "+v"(tid), "+v"(lane));
    LAS float* sc = (LAS float*)lds;
    LAS float* red = sc + 3 * 1024;
    const int layer = unit / 36, cb = unit % 36;
    for (int i = tid; i < 3072; i += NTHREADS) { const int b = i >> 10, k = i & 1023; const float v = (b < 2) ? c[b * 1024 + k] : cctx[k]; sc[i] = v / (1.0f + __expf(-v)); }
    __syncthreads();
    const float* wp = w_ada + ((size_t)layer * 1024 + wave * 128) * 9216 + cb * 256 + lane * 4;
    f32x4 a0 = {0.f, 0.f, 0.f, 0.f}, a1 = a0, a2 = a0;
#pragma unroll 16
    for (int kk = 0; kk < 128; ++kk) { const f32x4 w = __builtin_nontemporal_load((const f32x4*)(wp + (size_t)kk * 9216)); const int k = wave * 128 + kk;
        a0 += w * sc[k]; a1 += w * sc[1024 + k]; a2 += w * sc[2048 + k]; }
    *(LAS f32x4*)(red + (wave * 3 + 0) * 256 + lane * 4) = a0; *(LAS f32x4*)(red + (wave * 3 + 1) * 256 + lane * 4) = a1; *(LAS f32x4*)(red + (wave * 3 + 2) * 256 + lane * 4) = a2;
    __syncthreads();
    for (int o = tid; o < 768; o += NTHREADS) { const int b = o >> 8, col = o & 255; float s = b_ada[layer * 9216 + cb * 256 + col];
#pragma unroll
        for (int w = 0; w < 8; ++w) s += red[(w * 3 + b) * 256 + col];
        MOD[(size_t)(layer * 3 + b) * 9216 + cb * 256 + col] = s; }
    __syncthreads();
}

struct ThinP { int first, has_y, lp, gate_i, gpost_i; float wgt; int has_next, ln, gpre_i, shift_i, scale_i; };
#define TCOL(j) (8 * lane + 512 * ((j) >> 1) + 4 * ((j) & 1))
__device__ __forceinline__ void thin_unpack(const u32x4 w, f32x4& lo, f32x4& hi) { lo = (f32x4){bflo(w.x), bfhi(w.x), bflo(w.y), bfhi(w.y)}; hi = (f32x4){bflo(w.z), bfhi(w.z), bflo(w.w), bfhi(w.w)}; }
__device__ __forceinline__ u32x4 thin_pack(const f32x4 lo, const f32x4 hi) { u32x4 w; w.x = cvtpk(lo.x, lo.y); w.y = cvtpk(lo.z, lo.w); w.z = cvtpk(hi.x, hi.y); w.w = cvtpk(hi.z, hi.w); return w; }
__device__ __forceinline__ void thin_load(const ThinP& p, int r, const float* xin, const float* ctxin, const bf16_t* X, const float* CTXS, const bf16_t* Y, const float* YCP, int nks, int lane, f32x4 (&x)[4], f32x4 (&y)[4]) {
    if (p.first || r >= ML) {
        const float* src = p.first ? ((r < ML) ? xin + (size_t)r * D : ctxin + (size_t)(r - ML) * D) : CTXS + (size_t)(r - ML) * D;
#pragma unroll
        for (int j = 0; j < 4; ++j) x[j] = *(const f32x4*)(src + TCOL(j));
    } else {
#pragma unroll
        for (int c2 = 0; c2 < 2; ++c2) thin_unpack(*(const u32x4*)(X + (size_t)r * D + TCOL(2 * c2)), x[2 * c2], x[2 * c2 + 1]);
    }
    if (p.has_y) {
        if (r < ML) {
#pragma unroll
            for (int c2 = 0; c2 < 2; ++c2) thin_unpack(*(const u32x4*)(Y + (size_t)r * D + TCOL(2 * c2)), y[2 * c2], y[2 * c2 + 1]);
        } else {
#pragma unroll 1
            for (int j2 = 0; j2 < 2; ++j2) { f32x4 pv[2][12];
#pragma unroll
                for (int jj = 0; jj < 2; ++jj)
#pragma unroll
                    for (int kz = 0; kz < 12; ++kz) pv[jj][kz] = (kz < nks) ? *(const f32x4*)(YCP + ((size_t)kz * MC + (r - ML)) * D + TCOL(2 * j2 + jj)) : (f32x4){0.f, 0.f, 0.f, 0.f};
                f32x4 a = pv[0][0], c = pv[1][0];
#pragma unroll
                for (int kz = 1; kz < 12; ++kz) { a += pv[0][kz]; c += pv[1][kz]; }
                if (j2 == 0) { y[0] = a; y[1] = c; } else { y[2] = a; y[3] = c; } }
        }
    }
}
struct ThinVec { f32x4 cpost[4], cpre[4], csh[4]; };
__device__ __forceinline__ void thin_vecs(const ThinP& p, int bsel, const float* MOD, const float* normg, int lane, ThinVec& v) {
    if (p.has_y) { const float* gate = MOD + (size_t)(p.lp * 3 + bsel) * 9216 + p.gate_i * D; const float* gp = normg + (size_t)(p.lp * 6 + p.gpost_i) * D;
#pragma unroll
        for (int j = 0; j < 4; ++j) v.cpost[j] = *(const f32x4*)(gate + TCOL(j)) * *(const f32x4*)(gp + TCOL(j)) * p.wgt; }
    if (p.has_next) { const float* mb = MOD + (size_t)(p.ln * 3 + bsel) * 9216; const float* gp = normg + (size_t)(p.ln * 6 + p.gpre_i) * D;
#pragma unroll
        for (int j = 0; j < 4; ++j) { const int cc = TCOL(j); v.cpre[j] = *(const f32x4*)(gp + cc) * (*(const f32x4*)(mb + p.scale_i * D + cc) + 1.0f); v.csh[j] = *(const f32x4*)(mb + p.shift_i * D + cc); } }
}
__device__ __forceinline__ void thin_row(const ThinP& p, int r, bf16_t* X, float* OUTF, float* CTXS, bf16_t* XN, const ThinVec& tv, int lane, f32x4 (&x)[4], const f32x4 (&y)[4]) {
    if (p.has_y) {
        float ss = 0.f;
#pragma unroll
        for (int j = 0; j < 4; ++j) ss += (y[j].x * y[j].x + y[j].y * y[j].y) + (y[j].z * y[j].z + y[j].w * y[j].w);
        const float rinv = 1.0f / sqrtf(wave_sum(ss) * (1.0f / D) + EPS);
#pragma unroll
        for (int j = 0; j < 4; ++j) x[j] += tv.cpost[j] * y[j] * rinv;
    }
    if (p.has_y) {
        if (r >= ML || !p.has_next) { float* xr = (r < ML) ? OUTF + (size_t)r * D : CTXS + (size_t)(r - ML) * D;
#pragma unroll
            for (int j = 0; j < 4; ++j) pg8::st16_wt(xr + TCOL(j), __builtin_bit_cast(u32x4, x[j]));
        } else {
#pragma unroll
            for (int c2 = 0; c2 < 2; ++c2) pg8::st16_wt(X + (size_t)r * D + TCOL(2 * c2), thin_pack(x[2 * c2], x[2 * c2 + 1]));
        }
    }
    if (p.has_next) {
        float ss = 0.f;
#pragma unroll
        for (int j = 0; j < 4; ++j) ss += (x[j].x * x[j].x + x[j].y * x[j].y) + (x[j].z * x[j].z + x[j].w * x[j].w);
        const float rinv = 1.0f / sqrtf(wave_sum(ss) * (1.0f / D) + EPS);
#pragma unroll
        for (int c2 = 0; c2 < 2; ++c2) { const f32x4 o0 = x[2 * c2] * rinv * tv.cpre[2 * c2] + tv.csh[2 * c2], o1 = x[2 * c2 + 1] * rinv * tv.cpre[2 * c2 + 1] + tv.csh[2 * c2 + 1];
            pg8::st16_wt(XN + (size_t)r * D + TCOL(2 * c2), thin_pack(o0, o1)); }
    }
}
__device__ __forceinline__ void thin_phase(const ThinP p, const float* xin, const float* ctxin, const bf16_t* Xr, bf16_t* X, float* OUTF, float* CTXS, const bf16_t* Y, const float* YCP, int nks, bf16_t* XN, const float* MOD, const float* normg, int gw, int NGW, int lane) {
    asm volatile("" : "+v"(lane));
    for (int r0 = gw; r0 < ML; r0 += 4 * NGW) {
        const int r1 = r0 + NGW, r2 = r0 + 2 * NGW, r3 = r0 + 3 * NGW; const bool has1 = r1 < ML, has2 = r2 < ML, has3 = r3 < ML;
        f32x4 x0[4], y0[4], x1[4], y1[4], x2[4], y2[4], x3[4], y3[4];
        thin_load(p, r0, xin, ctxin, Xr, CTXS, Y, YCP, 0, lane, x0, y0);
        if (has1) thin_load(p, r1, xin, ctxin, Xr, CTXS, Y, YCP, 0, lane, x1, y1);
        if (has2) thin_load(p, r2, xin, ctxin, Xr, CTXS, Y, YCP, 0, lane, x2, y2);
        if (has3) thin_load(p, r3, xin, ctxin, Xr, CTXS, Y, YCP, 0, lane, x3, y3);
        const int bs0 = r0 >> 13;
        ThinVec tv; thin_vecs(p, bs0, MOD, normg, lane, tv);
        thin_row(p, r0, X, OUTF, CTXS, XN, tv, lane, x0, y0);
        if (has1) { const int b1 = r1 >> 13; if (b1 != bs0) thin_vecs(p, b1, MOD, normg, lane, tv); thin_row(p, r1, X, OUTF, CTXS, XN, tv, lane, x1, y1);
            if (has2) { const int b2 = r2 >> 13; if (b2 != b1) thin_vecs(p, b2, MOD, normg, lane, tv); thin_row(p, r2, X, OUTF, CTXS, XN, tv, lane, x2, y2);
                if (has3) { const int b3 = r3 >> 13; if (b3 != b2) thin_vecs(p, b3, MOD, normg, lane, tv); thin_row(p, r3, X, OUTF, CTXS, XN, tv, lane, x3, y3); } } }
    }
    if (nks >= 0) for (int r = ML + gw; r < R; r += NGW) {
        f32x4 x0[4], y0[4];
        thin_load(p, r, xin, ctxin, Xr, CTXS, Y, YCP, nks, lane, x0, y0);
        ThinVec tv; thin_vecs(p, 2, MOD, normg, lane, tv);
        thin_row(p, r, X, OUTF, CTXS, XN, tv, lane, x0, y0);
    }
}

__device__ __forceinline__ int pos_row(int b, int P) { return (P < CTXL) ? ML + b * CTXL + P : b * SEQ + (P - CTXL); }
__device__ __forceinline__ size_t hbase(int b, int h, int c) { return ((size_t)(b * 4 + h) * NPOS + 64 * c) * 512; }
__device__ __forceinline__ int chunk_row0(int b, int c) { return (c < 4) ? ML + b * CTXL + 64 * c : b * SEQ + 64 * (c - 4); }

__device__ __forceinline__ void wcm_item(const float* wqkv, const float* wg, bf16_t* wcm, int idx) {
    const int li = idx >> 15, c = (idx >> 4) & 2047, g = idx & 15, n = c >> 2, i = c & 3;
    const float* wq = wqkv + ((size_t)(li * 3 + 0) * 512 + n) * 16; const float* wk = wqkv + ((size_t)(li * 3 + 1) * 512 + n) * 16; const float* wv = wqkv + ((size_t)(li * 3 + 2) * 512 + n) * 16;
    const float* G = wg + (size_t)li * 6144 * 16;
    float sc = 0.f, sm = 0.f;
#pragma unroll
    for (int o = 0; o < 4; ++o) { sc += wq[o * 4 + i] * G[(size_t)(4 * n + o) * 16 + g] + wk[o * 4 + i] * G[(size_t)(2048 + 4 * n + o) * 16 + g]; sm += wv[o * 4 + i] * G[(size_t)(4096 + 4 * n + o) * 16 + g]; }
    const int ks = c >> 5, ln = ((c >> 3) & 3) * 16 + g, jj = c & 7;
    wcm[(((size_t)li * 128 + ks) * 64 + ln) * 8 + jj] = f2bf(sc); wcm[(((size_t)li * 128 + 64 + ks) * 64 + ln) * 8 + jj] = f2bf(sm);
}
__device__ __forceinline__ void gates_weights(const bf16_t* wcmb, int wave, int lane, bf16x8 (&b0)[8], bf16x8 (&b1)[8]) {
    const bf16_t* bp = wcmb + (size_t)lane * 8 + (size_t)(8 * wave) * 512;
#pragma unroll
    for (int ks = 0; ks < 8; ++ks) { b0[ks] = *(const bf16x8*)(bp + (size_t)ks * 512); b1[ks] = *(const bf16x8*)(bp + (size_t)(64 + ks) * 512); }
}
__device__ __forceinline__ void gates_tile(const bf16_t* XC, const bf16_t* XM, const bf16x8 (&b0)[8], const bf16x8 (&b1)[8], const float* bg, float* GATES, LAS float* red, int tile, int wave, int lane) {
    const int r0 = 16 * tile;
    const bf16_t* ac = XC + (size_t)(r0 + (lane & 15)) * DI + 8 * (lane >> 4) + 256 * wave; const bf16_t* am = XM + (size_t)(r0 + (lane & 15)) * DI + 8 * (lane >> 4) + 256 * wave;
    bf16x8 a0[8], a1[8];
#pragma unroll
    for (int ks = 0; ks < 8; ++ks) { a0[ks] = *(const bf16x8*)(ac + 32 * ks); a1[ks] = *(const bf16x8*)(am + 32 * ks); }
    f32x4 acc0 = {0.f, 0.f, 0.f, 0.f}, acc1 = acc0;
#pragma unroll
    for (int ks = 0; ks < 8; ++ks) { acc0 = mfma16(a0[ks], b0[ks], acc0); acc1 = mfma16(a1[ks], b1[ks], acc1); }
    *(LAS f32x4*)(red + wave * 256 + lane * 4) = acc0 + acc1;
    __syncthreads();
    if (wave == 0) { f32x4 t = *(const LAS f32x4*)(red + lane * 4);
#pragma unroll
        for (int w = 1; w < 8; ++w) t += *(const LAS f32x4*)(red + w * 256 + lane * 4);
        const float bb = bg[lane & 15];
#pragma unroll
        for (int rg = 0; rg < 4; ++rg) GATES[(size_t)(lane & 15) * R + (r0 + 4 * (lane >> 4) + rg)] = t[rg] + bb; }
    __syncthreads();
}

__device__ __forceinline__ void phase_a2(const bf16_t* XM, bf16_t* XC, bf16_t* Q, bf16_t* K, bf16_t* V, const float* convw, const float* convb, const float* wqkv, int vcu, int G, int wave, int lane) {
    asm volatile("" : "+v"(lane));
    const int c0 = 256 * wave + 4 * lane;
    f32x4 cw[9], cb, wb[3][4];
#pragma unroll
    for (int t = 0; t < 9; ++t) cw[t] = *(const f32x4*)(convw + (size_t)t * DI + c0);
    cb = *(const f32x4*)(convb + c0);
#pragma unroll
    for (int part = 0; part < 3; ++part) { f32x4 rw[4];
#pragma unroll
        for (int o = 0; o < 4; ++o) rw[o] = *(const f32x4*)(wqkv + ((size_t)part * 512 + (c0 >> 2)) * 16 + 4 * o);
        const float osc = (part == 1) ? 0.04419417382415922f : 1.0f;
        wb[part][0] = (f32x4){rw[0].x, rw[1].x, rw[2].x, rw[3].x} * osc; wb[part][1] = (f32x4){rw[0].y, rw[1].y, rw[2].y, rw[3].y} * osc;
        wb[part][2] = (f32x4){rw[0].z, rw[1].z, rw[2].z, rw[3].z} * osc; wb[part][3] = (f32x4){rw[0].w, rw[1].w, rw[2].w, rw[3].w} * osc; }
    u32x2 tp[3][6], tn[3][6];
#define A2_LOAD(dst, qi) do { const int r0_ = 4 * (qi); int rb_, gr_, gc_, nr_, nc_; \
        if (r0_ < ML) { const int b_ = r0_ >> 13, t0_ = r0_ & (SEQ - 1); rb_ = b_ * SEQ; gr_ = t0_ >> 6; gc_ = t0_ & 63; nr_ = SEQ / 64; nc_ = 64; } \
        else { const int b_ = (r0_ - ML) >> 8; rb_ = ML + b_ * CTXL; gr_ = 0; gc_ = (r0_ - ML) & (CTXL - 1); nr_ = 1; nc_ = CTXL; } \
        _Pragma("unroll") for (int dr = 0; dr < 3; ++dr) { const int rr = gr_ + dr - 1; const bool rok = (rr >= 0) && (rr < nr_); \
            _Pragma("unroll") for (int dc = 0; dc < 6; ++dc) { const int cc = gc_ + dc - 1; const bool ok = rok && (cc >= 0) && (cc < nc_); \
                u32x2 w_ = {0u, 0u}; if (ok) w_ = *(const u32x2*)(XM + (size_t)(rb_ + rr * nc_ + cc) * DI + c0); dst[dr][dc] = w_; } } } while (0)
#define A2_BODY(tp) do { \
        const int r0 = 4 * qi; \
        const int hb4 = (r0 < ML) ? (r0 >> 13) * 4 : ((r0 - ML) >> 8) * 4, P0 = (r0 < ML) ? CTXL + (r0 & (SEQ - 1)) : ((r0 - ML) & (CTXL - 1)); \
_Pragma("unroll") \
        for (int tk = 0; tk < 4; ++tk) { \
            f32x4 a = cb; \
_Pragma("unroll") \
            for (int dr = 0; dr < 3; ++dr) \
_Pragma("unroll") \
                for (int dc = 0; dc < 3; ++dc) { const u32x2 w = tp[dr][tk + dc]; a += cw[dr * 3 + dc] * (f32x4){bflo(w.x), bfhi(w.x), bflo(w.y), bfhi(w.y)}; } \
            const f32x4 xc = {silu_f(a.x), silu_f(a.y), silu_f(a.z), silu_f(a.w)}; \
            const u32x2 wm = tp[1][tk + 1]; const f32x4 xm = {bflo(wm.x), bfhi(wm.x), bflo(wm.y), bfhi(wm.y)}; \
            { u32x2 o; o.x = cvtpk(xc.x, xc.y); o.y = cvtpk(xc.z, xc.w); *(u32x2*)(XC + (size_t)(r0 + tk) * DI + c0) = o; } \
_Pragma("unroll") \
            for (int part = 0; part < 3; ++part) { \
                const f32x4 sv = (part == 2) ? xm : xc; \
                const f32x4 o4 = (wb[part][0] * sv.x + wb[part][1] * sv.y) + (wb[part][2] * sv.z + wb[part][3] * sv.w); \
                u32x2 ow; ow.x = cvtpk(o4.x, o4.y); ow.y = cvtpk(o4.z, o4.w); \
                bf16_t* dst = (part == 0) ? Q : (part == 1) ? K : V; \
                *(u32x2*)(dst + ((size_t)(hb4 + (c0 >> 9)) * NPOS + P0 + tk) * 512 + (c0 & 511)) = ow; \
            } \
        } \
    } while (0)
    if (G == 256) {
        const int b_ = vcu >> 7, gc = 4 * ((vcu >> 3) & 15), gr0 = 16 * (vcu & 7), rb = b_ * SEQ;
        f32x4 T0[6], T1[6], T2[6]; u32x2 nx[6];
#define A2_ROWREQ(rr) do { const int rr_ = (rr); const bool rok_ = (rr_ >= 0) && (rr_ < SEQ / 64); \
            _Pragma("unroll") for (int dc = 0; dc < 6; ++dc) { const int cc = gc + dc - 1; u32x2 w_ = {0u, 0u}; \
                if (rok_ && cc >= 0 && cc < 64) w_ = *(const u32x2*)(XM + (size_t)(rb + rr_ * 64 + cc) * DI + c0); nx[dc] = w_; } } while (0)
#define A2_ROWGET(Tx) do { _Pragma("unroll") for (int dc = 0; dc < 6; ++dc) Tx[dc] = (f32x4){bflo(nx[dc].x), bfhi(nx[dc].x), bflo(nx[dc].y), bfhi(nx[dc].y)}; } while (0)
#define A2_STRIP(top, mid, bot, it) do { const int gr = gr0 + (it); \
            A2_ROWREQ(gr + 2);        \
            const int r0 = rb + gr * 64 + gc, hb4 = b_ * 4, P0 = CTXL + gr * 64 + gc; \
            _Pragma("unroll") for (int tk = 0; tk < 4; ++tk) { \
                f32x4 a = cb; \
                _Pragma("unroll") for (int dc = 0; dc < 3; ++dc) { a += cw[dc] * top[tk + dc]; a += cw[3 + dc] * mid[tk + dc]; a += cw[6 + dc] * bot[tk + dc]; } \
                const f32x4 xc = {silu_f(a.x), silu_f(a.y), silu_f(a.z), silu_f(a.w)}; \
                const f32x4 xm = mid[tk + 1]; \
                { u32x2 o; o.x = cvtpk(xc.x, xc.y); o.y = cvtpk(xc.z, xc.w); *(u32x2*)(XC + (size_t)(r0 + tk) * DI + c0) = o; } \
                _Pragma("unroll") for (int part = 0; part < 3; ++part) { \
                    const f32x4 sv = (part == 2) ? xm : xc; \
                    const f32x4 o4 = (wb[part][0] * sv.x + wb[part][1] * sv.y) + (wb[part][2] * sv.z + wb[part][3] * sv.w); \
                    u32x2 ow; ow.x = cvtpk(o4.x, o4.y); ow.y = cvtpk(o4.z, o4.w); \
                    bf16_t* dst = (part == 0) ? Q : (part == 1) ? K : V; \
                    *(u32x2*)(dst + ((size_t)(hb4 + (c0 >> 9)) * NPOS + P0 + tk) * 512 + (c0 & 511)) = ow; } } \
            A2_ROWGET(top); } while (0)
        A2_ROWREQ(gr0 - 1); A2_ROWGET(T0); A2_ROWREQ(gr0); A2_ROWGET(T1); A2_ROWREQ(gr0 + 1); A2_ROWGET(T2);
        for (int it = 0; it < 16; it += 3) {
            A2_STRIP(T0, T1, T2, it);
            if (it + 1 < 16) A2_STRIP(T1, T2, T0, it + 1);
            if (it + 2 < 16) A2_STRIP(T2, T0, T1, it + 2);
        }
#undef A2_STRIP
#undef A2_ROWGET
#undef A2_ROWREQ
        if (vcu < (R - ML) / 4) { const int qi = ML / 4 + vcu; A2_LOAD(tp, qi); A2_BODY(tp); }
    } else {
    int qi = vcu;
    if (qi < R / 4) A2_LOAD(tp, qi);
    for (; qi < R / 4; qi += 2 * G) {
        { const int qn = qi + G; if (qn < R / 4) A2_LOAD(tn, qn); }
        A2_BODY(tp);
        { const int q1 = qi + G; if (q1 >= R / 4) break;
          const int qn = q1 + G; if (qn < R / 4) A2_LOAD(tp, qn);
          const int qi_keep = qi; qi = q1; A2_BODY(tn); qi = qi_keep; }
    }
    }
#undef A2_BODY
#undef A2_LOAD
}

__device__ __forceinline__ float wave_incl_sum(float v, int) {
    v += dpp_get<0x111, 0xf>(0.f, v); v += dpp_get<0x112, 0xf>(0.f, v); v += dpp_get<0x114, 0xf>(0.f, v); v += dpp_get<0x118, 0xf>(0.f, v);
    v += dpp_get<0x142, 0xa>(0.f, v); v += dpp_get<0x143, 0xc>(0.f, v);
    return v;
}
__device__ __forceinline__ float wave_incl_max(float v, int) {
    const float ni = -__builtin_inff();
    v = fmaxf(v, dpp_get<0x111, 0xf>(ni, v)); v = fmaxf(v, dpp_get<0x112, 0xf>(ni, v)); v = fmaxf(v, dpp_get<0x114, 0xf>(ni, v)); v = fmaxf(v, dpp_get<0x118, 0xf>(ni, v));
    v = fmaxf(v, dpp_get<0x142, 0xa>(ni, v)); v = fmaxf(v, dpp_get<0x143, 0xc>(ni, v));
    return v;
}
__device__ __forceinline__ float logsigmoid_f(float x) { return fminf(x, 0.f) - log1pf(__expf(-fabsf(x))); }
__device__ __forceinline__ int stream_chunk(int dir, int sc) { return dir ? ((sc < 4) ? 3 - sc : 135 - sc) : sc; }

__device__ __forceinline__ void gate_scan(const float* GATES, float* GM, LAS float* Bl, LAS float* Al, LAS float* Il, LAS float* tot, LAS float* mxs, int s, bool store_gm, int wave, int lane) {
    const int dir = s >> 3, b = (s >> 2) & 1, h = s & 3;
    constexpr int NPW = (NCHUNK + NWAVES - 1) / NWAVES;
    float gfv[NPW], giv[NPW];
#pragma unroll
    for (int q = 0; q < NPW; ++q) { const int sc = wave + NWAVES * q; gfv[q] = 0.f; giv[q] = 0.f;
        if (sc < NCHUNK) { const int c = stream_chunk(dir, sc), P = 64 * c + (dir ? 63 - lane : lane), row = pos_row(b, P);
            gfv[q] = GATES[(size_t)((dir * 2 + 1) * 4 + h) * R + row]; giv[q] = GATES[(size_t)((dir * 2 + 0) * 4 + h) * R + row]; } }
#pragma unroll
    for (int q = 0; q < NPW; ++q) { const int sc = wave + NWAVES * q;
        if (sc < NCHUNK) { const float ps = wave_incl_sum(logsigmoid_f(gfv[q]), lane); Bl[sc * 64 + lane] = ps; if (lane == 63) tot[sc] = ps; } }
    __syncthreads();
    if (wave == 0) { float carry = 0.f;
        for (int i0 = 0; i0 < NCHUNK; i0 += 64) { const int i = i0 + lane; const float v = (i < NCHUNK) ? tot[i] : 0.f; const float inc = wave_incl_sum(v, lane);
            if (i < NCHUNK) tot[i] = carry + inc - v; carry += __shfl(inc, 63); } }
    __syncthreads();
#pragma unroll
    for (int q = 0; q < NPW; ++q) { const int sc = wave + NWAVES * q;
        if (sc < NCHUNK) { const float gi = giv[q]; const float B = Bl[sc * 64 + lane] + tot[sc]; const float pm = wave_incl_max(gi - B, lane);
            Bl[sc * 64 + lane] = B; Al[sc * 64 + lane] = pm; Il[sc * 64 + lane] = gi; if (lane == 63) mxs[sc] = pm; } }
    __syncthreads();
    if (wave == 0) { float carry = 0.f;
        for (int i0 = 0; i0 < NCHUNK; i0 += 64) { const int i = i0 + lane; const float v = (i < NCHUNK) ? mxs[i] : -3.0e38f; const float inc = wave_incl_max(v, lane);
            float ex = __shfl_up(inc, 1); if (lane == 0) ex = -3.0e38f; ex = fmaxf(ex, carry);
            if (i < NCHUNK) mxs[i] = ex; carry = fmaxf(carry, __shfl(inc, 63)); } }
    __syncthreads();
    for (int sc = wave; sc < NCHUNK; sc += NWAVES) {
        const int c = stream_chunk(dir, sc), P = 64 * c + (dir ? 63 - lane : lane);
        const float m = Bl[sc * 64 + lane] + fmaxf(mxs[sc], Al[sc * 64 + lane]);
        Al[sc * 64 + lane] = m; if (store_gm) GM[(size_t)s * NPOS + P] = m;
    }
    __syncthreads();
}

__device__ __forceinline__ void phase_a3(bf16_t* Q, bf16_t* K, bf16_t* V, bf16_t* SRAW, const bf16_t* XC, const bf16_t* XM, const bf16_t* wcmb, const float* bg, float* GATES, LAS unsigned char* lds, int vcu, int G, int tid, int wave, int lane) {
    asm volatile("" : "+v"(tid), "+v"(lane));
    constexpr int PITCH = 520;
    LAS bf16_t* KL = (LAS bf16_t*)lds;
    LAS bf16_t* QL = KL + 64 * PITCH;
    { bf16x8 gb0[8], gb1[8]; gates_weights(wcmb, wave, lane, gb0, gb1);
      for (int t16 = (vcu + G / 2) % G; t16 < R / 16; t16 += G) gates_tile(       XC, XM, gb0, gb1, bg, GATES, (LAS float*)lds, t16, wave, lane); }
#define A3_BAR() do { asm volatile("s_waitcnt lgkmcnt(0)" ::: "memory"); __builtin_amdgcn_s_barrier(); asm volatile("" ::: "memory"); } while (0)
#define A3_PTRS(u) const int bh_ = (u) / NCHUNK, c_ = (u) % NCHUNK, b_ = bh_ >> 2, h_ = bh_ & 3; \
        const size_t hb_ = hbase(b_, h_, c_); bf16_t* Kp = K + hb_; bf16_t* Qp = Q + hb_;
    u32x4 kr[8], qr[8];
    const int sr0 = tid >> 6, kc = tid & 63;
    int unit = vcu;
    if (unit < 8 * NCHUNK) { A3_PTRS(unit)
#pragma unroll
        for (int i = 0; i < 8; ++i) { kr[i] = *(const u32x4*)(Kp + (size_t)(sr0 + 8 * i) * 512 + 8 * kc); qr[i] = *(const u32x4*)(Qp + (size_t)(sr0 + 8 * i) * 512 + 8 * kc); } }
    for (; unit < 8 * NCHUNK; unit += G) {
        A3_PTRS(unit)
        const int nu = unit + G; const bool hn = nu < 8 * NCHUNK;
#pragma unroll
        for (int i = 0; i < 8; ++i) { *(LAS u32x4*)(KL + (sr0 + 8 * i) * PITCH + 8 * kc) = kr[i]; *(LAS u32x4*)(QL + (sr0 + 8 * i) * PITCH + 8 * kc) = qr[i]; }
        if (hn) { const int bh2 = nu / NCHUNK, c2 = nu % NCHUNK; const size_t hb2 = hbase(bh2 >> 2, bh2 & 3, c2); const bf16_t* Kn = K + hb2; const bf16_t* Qn = Q + hb2;
#pragma unroll
            for (int i = 0; i < 8; ++i) { kr[i] = *(const u32x4*)(Kn + (size_t)(sr0 + 8 * i) * 512 + 8 * kc); qr[i] = *(const u32x4*)(Qn + (size_t)(sr0 + 8 * i) * 512 + 8 * kc); } }
        A3_BAR();
#pragma unroll
        for (int i = 0; i < 8; ++i) { const int T = wave * 8 + i, ktg = T >> 1, ks = T & 1;
            unsigned short e[8];
#pragma unroll
            for (int q = 0; q < 8; ++q) e[q] = KL[(32 * ks + 8 * (lane >> 4) + q) * PITCH + 16 * ktg + (lane & 15)];
            u32x4 w; w.x = e[0] | ((unsigned)e[1] << 16); w.y = e[2] | ((unsigned)e[3] << 16); w.z = e[4] | ((unsigned)e[5] << 16); w.w = e[6] | ((unsigned)e[7] << 16);
            *(u32x4*)(Kp + (size_t)T * 512 + 8 * lane) = w; }
        {
            const int tt = wave >> 1, st0 = 2 * (wave & 1);
            f32x4 acc0 = {0.f, 0.f, 0.f, 0.f}, acc1 = acc0;
#pragma unroll
            for (int ks = 0; ks < 16; ++ks) { const bf16x8 a = *(const LAS bf16x8*)(QL + (16 * tt + (lane & 15)) * PITCH + 32 * ks + 8 * (lane >> 4));
                const bf16x8 b0 = *(const LAS bf16x8*)(KL + (16 * st0 + (lane & 15)) * PITCH + 32 * ks + 8 * (lane >> 4)), b1 = *(const LAS bf16x8*)(KL + (16 * st0 + 16 + (lane & 15)) * PITCH + 32 * ks + 8 * (lane >> 4));
                acc0 = mfma16(a, b0, acc0); acc1 = mfma16(a, b1, acc1);
                if ((ks & 1) == (wave & 1)) {
                    const LAS bf16_t* qrow = QL + (16 * tt + (lane & 15)) * PITCH + 32 * ks + 4 * (lane >> 4);
                    const u32x2 lo = *(const LAS u32x2*)qrow, hi = *(const LAS u32x2*)(qrow + 16);
                    u32x4 pk; pk.x = lo.x; pk.y = lo.y; pk.z = hi.x; pk.w = hi.y;
                    *(u32x4*)(Qp + (size_t)(tt * 16 + ks) * 512 + 8 * lane) = pk; } }
            bf16_t* sp = SRAW + (size_t)unit * 4096 + (16 * tt + 4 * (lane >> 4)) * 64 + 16 * st0 + (lane & 15);
#pragma unroll
            for (int rg = 0; rg < 4; ++rg) { sp[rg * 64] = f2bf(acc0[rg]); sp[rg * 64 + 16] = f2bf(acc1[rg]); }
        }
        A3_BAR();
    }
    __syncthreads();
#undef A3_BAR
#undef A3_PTRS
}

constexpr int TABW = 320;
__device__ __forceinline__ void phase_a3bc(const float* GATES, const bf16_t* SRAW, bf16_t* SDT, float* TAB, float* GM, LAS unsigned char* lds, int vcu, int tid, int wave, int lane) {
    asm volatile("" : "+v"(tid), "+v"(lane));
    LAS float* Bl = (LAS float*)lds; LAS float* Ml = Bl + NPOS; LAS float* Il = Ml + NPOS; LAS float* tot = Il + NPOS; LAS float* mxs = tot + 192;
    const int s = vcu >> 4, jj = vcu & 15, dir = s >> 3, b = (s >> 2) & 1, h = s & 3;
    gate_scan(GATES, GM, Bl, Ml, Il, tot, mxs, s, jj == 0, wave, lane);
    const int tt = wave >> 1, ks = wave & 1, t = 16 * tt + (lane & 15), s0 = 32 * ks + 8 * (lane >> 4);
    u32x4 swn = *(const u32x4*)(SRAW + ((size_t)((b * 4 + h) * NCHUNK + stream_chunk(dir, jj))) * 4096 + t * 64 + s0);
    for (int sc = jj; sc < NCHUNK; sc += 16) {
        const int c = stream_chunk(dir, sc);
        const u32x4 sw = swn;
        if (sc + 16 < NCHUNK) swn = *(const u32x4*)(SRAW + ((size_t)((b * 4 + h) * NCHUNK + stream_chunk(dir, sc + 16))) * 4096 + t * 64 + s0);
        const int tp = sc * 64 + (dir ? 63 - t : t);
        const float ct = Bl[tp] - Ml[tp];
        const float sv[8] = {bflo(sw.x), bfhi(sw.x), bflo(sw.y), bfhi(sw.y), bflo(sw.z), bfhi(sw.z), bflo(sw.w), bfhi(sw.w)};
        float d[8], acc = 0.f;
#pragma unroll
        for (int e = 0; e < 8; ++e) { const int ss = s0 + e, sp = sc * 64 + (dir ? 63 - ss : ss); const bool ok = dir ? (ss >= t) : (ss <= t);
            d[e] = sv[e] * __expf(ok ? (ct + Il[sp] - Bl[sp]) : -1.0e30f); acc += d[e]; }
        u32x4 o; o.x = cvtpk(d[0], d[1]); o.y = cvtpk(d[2], d[3]); o.z = cvtpk(d[4], d[5]); o.w = cvtpk(d[6], d[7]);
        *(u32x4*)(SDT + (((size_t)s * NCHUNK + c) * 8 + wave) * 512 + lane * 8) = o;
        acc += __shfl_xor(acc, 16); acc += __shfl_xor(acc, 32);
        float* tab = TAB + ((size_t)s * NCHUNK + c) * TABW;
        if (lane < 16) tab[128 + 64 * ks + t] = acc;
        if (wave < 2) {
            const int lp = sc * 64 + 63; const float dl = Bl[lp] - Ml[lp]; const float dp = (sc > 0) ? (Bl[sc * 64 - 1] - Ml[sc * 64 - 1]) : 0.f;
            const int pp = sc * 64 + (dir ? 63 - lane : lane);
            if (wave == 0) { tab[lane] = __expf(Bl[pp] - Ml[pp] - dp); if (lane == 0) tab[256] = __expf(dl - dp); }
            else tab[64 + lane] = __expf(dl + Il[pp] - Bl[pp]);
        }
    }
    __syncthreads();
}

__device__ __forceinline__ void phase_a4(const bf16_t* Q, const bf16_t* KT, const bf16_t* VT, const bf16_t* SDT, const float* TAB, bf16_t* NUMF, bf16_t* NUMB, float* PD,
                                         LAS unsigned char* lds, int vcu, int tid, int wave, int lane) {
    asm volatile("" : "+v"(tid), "+v"(lane));
    constexpr int SP = 72, RP = 36;
    LAS float* red = (LAS float*)lds;
    LAS bf16_t* VtL = (LAS bf16_t*)(red + 10 * 64 * RP);
    LAS bf16_t* VwL = VtL + 2 * 32 * SP;
    LAS float* nL = (LAS float*)(VwL + 2 * 32 * SP);
    LAS float* wL = nL + 64;
    LAS bf16_t* q4L = (LAS bf16_t*)(wL + 128);
    LAS bf16_t* k4L = q4L + 2 * 2048;
    const int s = vcu >> 4, j = vcu & 15, dir = s >> 3, b = (s >> 2) & 1, h = s & 3;
    bf16_t* NUM = dir ? NUMB : NUMF;
    const int tt = wave >> 1, vt = wave & 1, g = lane >> 4;
    f32x4 cacc[4][2];
#pragma unroll
    for (int kt = 0; kt < 4; ++kt)
#pragma unroll
        for (int v2 = 0; v2 < 2; ++v2) cacc[kt][v2] = (f32x4){0.f, 0.f, 0.f, 0.f};
    if (tid < 32) nL[tid] = 0.f;
    const int st_t = tid >> 3, kq = tid & 7;
    const int nk = tid >> 4, nsq = tid & 15;
    const unsigned o_q = (unsigned)(2 * wave) * 1024u + (unsigned)lane * 16u;
    const unsigned o_sd = (unsigned)wave * 1024u + (unsigned)lane * 16u;
    const unsigned o_t = (unsigned)st_t * 4u;
    const unsigned o_k = (unsigned)wave * 8192u + (unsigned)lane * 16u;
#define A4_T(x) ({ int t_ = tid; asm volatile("" : "+v"(t_)); (unsigned)(x); })
#define o_q4 A4_T(((t_ >> 7) * 512 + (((t_ >> 3) & 15) + 16 * (t_ & 3)) * 8 + 4 * ((t_ >> 2) & 1)) * 2)
#define o_k4 A4_T(((((t_ >> 8) * 2 + ((t_ >> 3) & 1)) * 512) + (((t_ >> 4) & 15) + 16 * ((t_ >> 1) & 3)) * 8 + 4 * (t_ & 1)) * 2)
#define o_v A4_T(((t_ >> 3) * 512 + 4 * (t_ & 7)) * 2)
#define o_n A4_T(((t_ >> 3) * DI + 4 * (t_ & 7)) * 2)
#define A4_LD(T, base, off) (*(const T*)((const char*)(base) + (off)))
    bf16x8 qfA[4][2], ktfA[2][4], sdfA, ktfB[2][4]; u32x2 vtw; float wv0; float sct_prev = 0.f, rs_prev = 0.f, dec_prev = 0.f; f32x4 wn4_prev = {0.f, 0.f, 0.f, 0.f};     float rs0A, rs1A, sctA, decA, decB;
#define A4_CH(stp) stream_chunk(dir, (stp))
#define A4_QB(c_) ((const char*)(Q + hbase(b, h, (c_))))
#define A4_KB(c_) ((const char*)(KT + hbase(b, h, (c_))))
#define A4_VB(c_) ((const char*)(VT + hbase(b, h, (c_))) + 64 * j)
#define A4_TB(c_) ((const char*)(TAB + ((size_t)s * NCHUNK + (c_)) * TABW))
#define A4_SDB(c_) ((const char*)(SDT + (((size_t)s * NCHUNK + (c_)) * 8) * 512))
#define A4_LOAD_STAGE(stp) do { const int c_ = A4_CH(stp); vtw = A4_LD(u32x2, A4_VB(c_), o_v); wv0 = A4_LD(float, A4_TB(c_) + 256, o_t); } while (0)
#define A4_LOAD_H(stp, QF, SDF, SCT, RS0, RS1) do { const int c_ = A4_CH(stp); const char* qb_ = A4_QB(c_); const char* tb_ = A4_TB(c_); const char* sb_ = A4_SDB(c_); \
        _Pragma("unroll") for (int i = 0; i < 4; ++i) _Pragma("unroll") for (int kp = 0; kp < 2; ++kp) QF[i][kp] = A4_LD(bf16x8, qb_ + (16 * i + kp) * 1024, o_q); \
        SDF = A4_LD(bf16x8, sb_, o_sd); \
        SCT = A4_LD(float, tb_, o_t); RS0 = A4_LD(float, tb_ + 512, o_t); RS1 = A4_LD(float, tb_ + 768, o_t); } while (0)
#define A4_LOAD_K(stp, KTF, DEC) do { const int c_ = A4_CH(stp); const char* kb_ = A4_KB(c_); \
        _Pragma("unroll") for (int ks = 0; ks < 2; ++ks) _Pragma("unroll") for (int kt = 0; kt < 4; ++kt) KTF[ks][kt] = A4_LD(bf16x8, kb_ + (2 * kt + ks) * 1024, o_k); \
        DEC = *(const float*)(A4_TB(c_) + 1024); } while (0)
#define A4_STAGE_V(pb) do { LAS bf16_t* vt_ = VtL + ((pb) * 32 + 4 * kq) * SP + st_t; LAS bf16_t* vw_ = VwL + ((pb) * 32 + 4 * kq) * SP + st_t; \
        vt_[0] = (bf16_t)(vtw.x & 0xffffu); vt_[SP] = (bf16_t)(vtw.x >> 16); vt_[2 * SP] = (bf16_t)(vtw.y & 0xffffu); vt_[3 * SP] = (bf16_t)(vtw.y >> 16); \
        const unsigned w01 = cvtpk(bflo(vtw.x) * wv0, bfhi(vtw.x) * wv0), w23 = cvtpk(bflo(vtw.y) * wv0, bfhi(vtw.y) * wv0); \
        vw_[0] = (bf16_t)(w01 & 0xffffu); vw_[SP] = (bf16_t)(w01 >> 16); vw_[2 * SP] = (bf16_t)(w23 & 0xffffu); vw_[3 * SP] = (bf16_t)(w23 >> 16); \
        if (kq == 0) wL[(pb) * 64 + st_t] = wv0; } while (0)
#define A4_BAR() do { asm volatile("s_waitcnt lgkmcnt(0)" ::: "memory"); __builtin_amdgcn_s_barrier(); asm volatile("" ::: "memory"); } while (0)
#define A4_SB() __builtin_amdgcn_sched_barrier(0)
#define A4_LAG(st, pr, pw) do { const int cl_ = A4_CH(st); \
        const u32x2 kt4 = *(const LAS u32x2*)((const LAS char*)(k4L + (pr) * 2048) + o_k4); const u32x2 q4 = *(const LAS u32x2*)((const LAS char*)(q4L + (pr) * 2048) + o_q4); \
        const f32x4 nl4 = *(const LAS f32x4*)(nL + 32 * (pr) + 4 * kq); const float nold = nL[32 * (pr) + nk]; \
        float acc = bflo(kt4.x) * wn4_prev.x + bfhi(kt4.x) * wn4_prev.y + bflo(kt4.y) * wn4_prev.z + bfhi(kt4.y) * wn4_prev.w; \
        acc = rowsum16(acc); \
        if (nsq == 15) nL[32 * (pw) + nk] = dec_prev * nold + acc; \
        float pacc = bflo(q4.x) * nl4.x + bfhi(q4.x) * nl4.y + bflo(q4.y) * nl4.z + bfhi(q4.y) * nl4.w; \
        pacc = rowsum8(pacc); \
        if (kq == 7) *(float*)((char*)(PD + ((size_t)s * NPOS + 64 * cl_) * 16 + j) + 16u * o_t) = sct_prev * pacc + ((j == 0) ? rs_prev : 0.f); } while (0)
#define A4_STEP(step, p, QF, SDF, SCT, RS0, RS1, KTF, DEC) do { \
        const int c = A4_CH(step), row0 = chunk_row0(b, c); \
        const int nx2 = ((step) + 2 < NCHUNK) ? (step) + 2 : NCHUNK - 1, nx1 = ((step) + 1 < NCHUNK) ? (step) + 1 : NCHUNK - 1; \
        const int c1_ = A4_CH(nx1), c2_ = A4_CH(nx2); \
        const char* tb1_ = A4_TB(c1_); const char* tb2_ = A4_TB(c2_); const char* q1_ = A4_QB(c1_); const char* k2_ = A4_KB(c2_); const char* sd1_ = A4_SDB(c1_); \
        A4_STAGE_V((p) ^ 1); \
        if (wave == (j >> 1)) {       \
            LAS bf16_t* qd_ = q4L + (p) * 2048 + lane * 8; LAS bf16_t* kd_ = k4L + (p) * 2048 + lane * 8; \
            if (j & 1) { _Pragma("unroll") for (int i = 0; i < 4; ++i) *(LAS bf16x8*)(qd_ + i * 512) = QF[i][1]; \
                _Pragma("unroll") for (int ktl = 0; ktl < 2; ++ktl) _Pragma("unroll") for (int ks = 0; ks < 2; ++ks) *(LAS bf16x8*)(kd_ + (ktl * 2 + ks) * 512) = KTF[ks][2 + ktl]; } \
            else { _Pragma("unroll") for (int i = 0; i < 4; ++i) *(LAS bf16x8*)(qd_ + i * 512) = QF[i][0]; \
                _Pragma("unroll") for (int ktl = 0; ktl < 2; ++ktl) _Pragma("unroll") for (int ks = 0; ks < 2; ++ks) *(LAS bf16x8*)(kd_ + (ktl * 2 + ks) * 512) = KTF[ks][ktl]; } } \
        A4_SB(); \
        A4_LOAD_STAGE(nx2); \
        A4_SB(); \
        { bf16x8 bst[2][2]; \
          _Pragma("unroll") for (int kp = 0; kp < 2; ++kp) _Pragma("unroll") for (int v2 = 0; v2 < 2; ++v2) { u32x4 pk; pk.x = cvtpk(cacc[2 * kp][v2][0], cacc[2 * kp][v2][1]); pk.y = cvtpk(cacc[2 * kp][v2][2], cacc[2 * kp][v2][3]); \
              pk.z = cvtpk(cacc[2 * kp + 1][v2][0], cacc[2 * kp + 1][v2][1]); pk.w = cvtpk(cacc[2 * kp + 1][v2][2], cacc[2 * kp + 1][v2][3]); bst[kp][v2] = __builtin_bit_cast(bf16x8, pk); } \
            \
          bf16x8 bb[2];        \
          _Pragma("unroll") for (int v2 = 0; v2 < 2; ++v2) bb[v2] = *(const LAS bf16x8*)(VtL + ((p) * 32 + 16 * v2 + (lane & 15)) * SP + 32 * vt + 8 * (lane >> 4)); \
          _Pragma("unroll") for (int i = 0; i < 4; ++i) { \
            _Pragma("unroll") for (int v2 = 0; v2 < 2; ++v2) { f32x4 hp = {0.f, 0.f, 0.f, 0.f}; \
              _Pragma("unroll") for (int kp = 0; kp < 2; ++kp) hp = mfma16(QF[i][kp], bst[kp][v2], hp); \
              LAS float* rp = red + (wave * 64 + 16 * i + 4 * g) * RP + 16 * v2 + (lane & 15); \
              rp[0] = hp[0]; rp[RP] = hp[1]; rp[2 * RP] = hp[2]; rp[3 * RP] = hp[3]; } \
            A4_SB(); \
            _Pragma("unroll") for (int kp = 0; kp < 2; ++kp) QF[i][kp] = A4_LD(bf16x8, q1_ + (16 * i + kp) * 1024, o_q); \
            A4_SB(); } \
            \
          _Pragma("unroll") for (int v2 = 0; v2 < 2; ++v2) { const f32x4 a2 = mfma16(SDF, bb[v2], (f32x4){0.f, 0.f, 0.f, 0.f}); \
            LAS float* ip = red + ((8 + vt) * 64 + 16 * tt + 4 * g) * RP + 16 * v2 + (lane & 15); \
            ip[0] = a2[0]; ip[RP] = a2[1]; ip[2 * RP] = a2[2]; ip[3 * RP] = a2[3]; } \
          A4_SB(); \
          SDF = A4_LD(bf16x8, sd1_, o_sd); \
          A4_SB(); \
        } \
        if ((step) > 0) { A4_LAG((step) - 1, (p) ^ 1, (p)); } \
        const float sct_cur = SCT; \
        sct_prev = SCT; rs_prev = RS0 + RS1; wn4_prev = *(const LAS f32x4*)(wL + (p) * 64 + 4 * nsq); \
        A4_SB(); \
        SCT = A4_LD(float, tb1_, o_t); RS0 = A4_LD(float, tb1_ + 512, o_t); RS1 = A4_LD(float, tb1_ + 768, o_t); \
        A4_SB(); \
        const float decay = DEC; dec_prev = decay; asm volatile("" : "+v"(dec_prev));        \
        _Pragma("unroll") for (int kt = 0; kt < 4; ++kt) _Pragma("unroll") for (int v2 = 0; v2 < 2; ++v2) cacc[kt][v2] *= decay; \
        A4_SB(); \
        A4_BAR(); \
          \
        { const LAS float* rp = red + st_t * RP + 4 * kq; \
          bf16x8 bw[2]; \
          f32x4 r0 = *(const LAS f32x4*)rp, r1 = *(const LAS f32x4*)(rp + 64 * RP); \
          _Pragma("unroll") for (int v2 = 0; v2 < 2; ++v2) bw[v2] = *(const LAS bf16x8*)(VwL + ((p) * 32 + 16 * v2 + (lane & 15)) * SP + 8 * (lane >> 4)); \
          _Pragma("unroll") for (int kt = 0; kt < 2; ++kt) _Pragma("unroll") for (int v2 = 0; v2 < 2; ++v2) cacc[kt][v2] = mfma16(KTF[0][kt], bw[v2], cacc[kt][v2]); \
          A4_SB(); \
          _Pragma("unroll") for (int kt = 0; kt < 2; ++kt) KTF[0][kt] = A4_LD(bf16x8, k2_ + (2 * kt) * 1024, o_k); \
          A4_SB(); \
          f32x4 r2 = *(const LAS f32x4*)(rp + 2 * 64 * RP), r3 = *(const LAS f32x4*)(rp + 3 * 64 * RP); \
          f32x4 sum = r0 + r1; \
          _Pragma("unroll") for (int kt = 2; kt < 4; ++kt) _Pragma("unroll") for (int v2 = 0; v2 < 2; ++v2) cacc[kt][v2] = mfma16(KTF[0][kt], bw[v2], cacc[kt][v2]); \
          A4_SB(); \
          _Pragma("unroll") for (int kt = 2; kt < 4; ++kt) KTF[0][kt] = A4_LD(bf16x8, k2_ + (2 * kt) * 1024, o_k); \
          A4_SB(); \
          r0 = *(const LAS f32x4*)(rp + 4 * 64 * RP); r1 = *(const LAS f32x4*)(rp + 5 * 64 * RP); \
          _Pragma("unroll") for (int v2 = 0; v2 < 2; ++v2) bw[v2] = *(const LAS bf16x8*)(VwL + ((p) * 32 + 16 * v2 + (lane & 15)) * SP + 32 + 8 * (lane >> 4)); \
          sum += r2 + r3; \
          _Pragma("unroll") for (int kt = 0; kt < 2; ++kt) _Pragma("unroll") for (int v2 = 0; v2 < 2; ++v2) cacc[kt][v2] = mfma16(KTF[1][kt], bw[v2], cacc[kt][v2]); \
          A4_SB(); \
          _Pragma("unroll") for (int kt = 0; kt < 2; ++kt) KTF[1][kt] = A4_LD(bf16x8, k2_ + (2 * kt + 1) * 1024, o_k); \
          A4_SB(); \
          r2 = *(const LAS f32x4*)(rp + 6 * 64 * RP); r3 = *(const LAS f32x4*)(rp + 7 * 64 * RP); \
          sum += r0 + r1; \
          r0 = *(const LAS f32x4*)(rp + 8 * 64 * RP); r1 = *(const LAS f32x4*)(rp + 9 * 64 * RP); \
          _Pragma("unroll") for (int kt = 2; kt < 4; ++kt) _Pragma("unroll") for (int v2 = 0; v2 < 2; ++v2) cacc[kt][v2] = mfma16(KTF[1][kt], bw[v2], cacc[kt][v2]); \
          A4_SB(); \
          _Pragma("unroll") for (int kt = 2; kt < 4; ++kt) KTF[1][kt] = A4_LD(bf16x8, k2_ + (2 * kt + 1) * 1024, o_k); \
          DEC = *(const float*)(tb2_ + 1024); \
          A4_SB(); \
          sum += r2 + r3; \
          const f32x4 hv = sum * sct_cur + (r0 + r1); \
          u32x2 o; o.x = cvtpk(hv.x, hv.y); o.y = cvtpk(hv.z, hv.w); \
          *(u32x2*)((char*)(NUM + (size_t)row0 * DI + h * DH + 32 * j) + o_n) = o; } \
        A4_BAR(); } while (0)
    A4_LOAD_STAGE(0);
    A4_STAGE_V(0);
    __builtin_amdgcn_sched_barrier(0);
    A4_LOAD_K(0, ktfA, decA);
    __builtin_amdgcn_sched_barrier(0);
    A4_LOAD_STAGE(1);
    __builtin_amdgcn_sched_barrier(0);
    A4_LOAD_H(0, qfA, sdfA, sctA, rs0A, rs1A);
    __builtin_amdgcn_sched_barrier(0);
    A4_LOAD_K(1, ktfB, decB);
    __builtin_amdgcn_sched_barrier(0);
    A4_BAR();
#pragma unroll 1
    for (int step = 0; step < NCHUNK; step += 2) {
        A4_STEP(step, 0, qfA, sdfA, sctA, rs0A, rs1A, ktfA, decA);
        A4_STEP(step + 1, 1, qfA, sdfA, sctA, rs0A, rs1A, ktfB, decB);
    }
    A4_LAG(NCHUNK - 1, (NCHUNK - 1) & 1, NCHUNK & 1);
    __syncthreads();
#undef A4_CH
#undef A4_LD
#undef A4_T
#undef o_q4
#undef o_k4
#undef o_v
#undef o_n
#undef A4_QB
#undef A4_KB
#undef A4_VB
#undef A4_TB
#undef A4_SDB
#undef A4_LOAD_STAGE
#undef A4_LOAD_H
#undef A4_LOAD_K
#undef A4_STAGE_V
#undef A4_BAR
#undef A4_SB
#undef A4_STEP
#undef A4_LAG
}

struct A5Row { u32x4 wf[4], wb[4], wx[4], wz[4]; float df, db, mf, mb; };
__device__ __forceinline__ void a5_load(A5Row& d, int r, const bf16_t* NUMF, const bf16_t* NUMB, const float* PD, const float* GM, const bf16_t* XC, const bf16_t* Z, int lane) {
    int b, P; if (r < ML) { b = r >> 13; P = CTXL + (r & (SEQ - 1)); } else { b = (r - ML) >> 8; P = (r - ML) & (CTXL - 1); }
#pragma unroll
    for (int h = 0; h < 4; ++h) { const int c0 = h * DH + 8 * lane;
        d.wf[h] = *(const u32x4*)(NUMF + (size_t)r * DI + c0); d.wb[h] = *(const u32x4*)(NUMB + (size_t)r * DI + c0); d.wx[h] = *(const u32x4*)(XC + (size_t)r * DI + c0); d.wz[h] = *(const u32x4*)(Z + (size_t)r * DI + c0); }
    const int hh = lane >> 4, jj = lane & 15, sf = b * 4 + hh, sb = 8 + b * 4 + hh;
    d.df = PD[((size_t)sf * NPOS + P) * 16 + jj]; d.db = PD[((size_t)sb * NPOS + P) * 16 + jj];
    d.mf = GM[(size_t)sf * NPOS + P]; d.mb = GM[(size_t)sb * NPOS + P];
}
__device__ __forceinline__ void a5_row(const A5Row& d, int r, bf16_t* G, const float* ang, const float* askip, int lane) {
    float df = d.df, db = d.db;
    df = rowsum16(df); db = rowsum16(db);
    const float nfl = 1.0f / fmaxf(fabsf(df), __expf(-d.mf)), nbl = 1.0f / fmaxf(fabsf(db), __expf(-d.mb));
    float hv[4][8], sm[4], sq[4];
#pragma unroll
    for (int h = 0; h < 4; ++h) {
        const float nf = __shfl(nfl, 16 * h + 15), nb = __shfl(nbl, 16 * h + 15);
        const u32x4 a = d.wf[h], c = d.wb[h];
        hv[h][0] = bflo(a.x) * nf + bflo(c.x) * nb; hv[h][1] = bfhi(a.x) * nf + bfhi(c.x) * nb; hv[h][2] = bflo(a.y) * nf + bflo(c.y) * nb; hv[h][3] = bfhi(a.y) * nf + bfhi(c.y) * nb;
        hv[h][4] = bflo(a.z) * nf + bflo(c.z) * nb; hv[h][5] = bfhi(a.z) * nf + bfhi(c.z) * nb; hv[h][6] = bflo(a.w) * nf + bflo(c.w) * nb; hv[h][7] = bfhi(a.w) * nf + bfhi(c.w) * nb;
        float s1 = 0.f, s2 = 0.f;
#pragma unroll
        for (int e = 0; e < 8; ++e) { s1 += hv[h][e]; s2 += hv[h][e] * hv[h][e]; }
        sm[h] = s1; sq[h] = s2;
    }
#pragma unroll
    for (int h = 0; h < 4; ++h) { sm[h] = wave_sum(sm[h]); sq[h] = wave_sum(sq[h]); }
#pragma unroll
    for (int h = 0; h < 4; ++h) {
        const int c0 = h * DH + 8 * lane;
        const float mu = sm[h] * (1.0f / DH); const float var = fmaxf(sq[h] * (1.0f / DH) - mu * mu, 0.f); const float rstd = 1.0f / sqrtf(var + EPS);
        const u32x4 x4 = d.wx[h], z4 = d.wz[h];
        const float xc[8] = {bflo(x4.x), bfhi(x4.x), bflo(x4.y), bfhi(x4.y), bflo(x4.z), bfhi(x4.z), bflo(x4.w), bfhi(x4.w)};
        const float zz[8] = {bflo(z4.x), bfhi(z4.x), bflo(z4.y), bfhi(z4.y), bflo(z4.z), bfhi(z4.z), bflo(z4.w), bfhi(z4.w)};
        const f32x4 g0 = *(const f32x4*)(ang + c0), g1 = *(const f32x4*)(ang + c0 + 4), k0 = *(const f32x4*)(askip + c0), k1 = *(const f32x4*)(askip + c0 + 4);
        const float gg[8] = {g0.x, g0.y, g0.z, g0.w, g1.x, g1.y, g1.z, g1.w}, kk[8] = {k0.x, k0.y, k0.z, k0.w, k1.x, k1.y, k1.z, k1.w};
        float o[8];
#pragma unroll
        for (int e = 0; e < 8; ++e) o[e] = ((hv[h][e] - mu) * rstd * gg[e] + kk[e] * xc[e]) * silu_f(zz[e]);
        u32x4 w; w.x = cvtpk(o[0], o[1]); w.y = cvtpk(o[2], o[3]); w.z = cvtpk(o[4], o[5]); w.w = cvtpk(o[6], o[7]);
        *(u32x4*)(G + (size_t)r * DI + c0) = w;
    }
}
__device__ __forceinline__ void phase_a5(const bf16_t* NUMF, const bf16_t* NUMB, const float* PD, const float* GM, const bf16_t* XC, const bf16_t* Z, bf16_t* G, const float* ang, const float* askip, int nrows, int gw, int NGW, int lane) {
    asm volatile("" : "+v"(lane));
    for (int r0 = gw; r0 < nrows; r0 += 2 * NGW) {
        const int r1 = r0 + NGW; const bool has1 = r1 < nrows;
        A5Row d0, d1;
        a5_load(d0, r0, NUMF, NUMB, PD, GM, XC, Z, lane);
        if (has1) a5_load(d1, r1, NUMF, NUMB, PD, GM, XC, Z, lane);
        a5_row(d0, r0, G, ang, askip, lane);
        if (has1) a5_row(d1, r1, G, ang, askip, lane);
    }
}

template <int OFF> __device__ __forceinline__ u32x2 lds_tr16(unsigned addr) { u32x2 r; asm volatile("ds_read_b64_tr_b16 %0, %1 offset:%2" : "=v"(r) : "v"(addr), "n"(OFF)); return r; }
template <int I> __device__ __forceinline__ void g2_pair(unsigned tr_lo, unsigned tr_hi, const bf16x8 (&bfr)[4], const u32x4 (&uwv)[12], float bsp, bf16_t* up) {
    constexpr int RPB = 784, C0 = 64 * I, C1 = 64 * I + 32, H = 4 * RPB, K1 = 32 * RPB;
#define G2_FR(l, h) __builtin_bit_cast(bf16x8, (u32x4){(l).x, (l).y, (h).x, (h).y})
    f32x4 acc0 = {0.f, 0.f, 0.f, 0.f}, acc1 = acc0;
    { u32x2 l0 = lds_tr16<C0>(tr_lo), h0 = lds_tr16<C0 + H>(tr_lo), l1 = lds_tr16<C0 + K1>(tr_lo), h1 = lds_tr16<C0 + K1 + H>(tr_lo);
      u32x2 l2 = lds_tr16<C0>(tr_hi), h2 = lds_tr16<C0 + H>(tr_hi), l3 = lds_tr16<C0 + K1>(tr_hi), h3 = lds_tr16<C0 + K1 + H>(tr_hi);
      asm volatile("s_waitcnt lgkmcnt(0)" : "+v"(l0), "+v"(h0), "+v"(l1), "+v"(h1), "+v"(l2), "+v"(h2), "+v"(l3), "+v"(h3));
      acc0 = mfma16(G2_FR(l0, h0), bfr[0], acc0); acc0 = mfma16(G2_FR(l1, h1), bfr[1], acc0); acc0 = mfma16(G2_FR(l2, h2), bfr[2], acc0); acc0 = mfma16(G2_FR(l3, h3), bfr[3], acc0); }
    { u32x2 l0 = lds_tr16<C1>(tr_lo), h0 = lds_tr16<C1 + H>(tr_lo), l1 = lds_tr16<C1 + K1>(tr_lo), h1 = lds_tr16<C1 + K1 + H>(tr_lo);
      u32x2 l2 = lds_tr16<C1>(tr_hi), h2 = lds_tr16<C1 + H>(tr_hi), l3 = lds_tr16<C1 + K1>(tr_hi), h3 = lds_tr16<C1 + K1 + H>(tr_hi);
      asm volatile("s_waitcnt lgkmcnt(0)" : "+v"(l0), "+v"(h0), "+v"(l1), "+v"(h1), "+v"(l2), "+v"(h2), "+v"(l3), "+v"(h3));
      acc1 = mfma16(G2_FR(l0, h0), bfr[0], acc1); acc1 = mfma16(G2_FR(l1, h1), bfr[1], acc1); acc1 = mfma16(G2_FR(l2, h2), bfr[2], acc1); acc1 = mfma16(G2_FR(l3, h3), bfr[3], acc1); }
#undef G2_FR
    const u32x4 uw = uwv[I];
    u32x4 o; o.x = cvtpk(bflo(uw.x) * (acc0[0] + bsp), bfhi(uw.x) * (acc0[1] + bsp)); o.y = cvtpk(bflo(uw.y) * (acc0[2] + bsp), bfhi(uw.y) * (acc0[3] + bsp));
    o.z = cvtpk(bflo(uw.z) * (acc1[0] + bsp), bfhi(uw.z) * (acc1[1] + bsp)); o.w = cvtpk(bflo(uw.w) * (acc1[2] + bsp), bfhi(uw.w) * (acc1[3] + bsp));
    *(u32x4*)(up + 32 * I) = o;
}
__device__ __forceinline__ void g2_pairs(unsigned tr_lo, unsigned tr_hi, const bf16x8 (&bfr)[4], const u32x4 (&uwv)[12], float bsp, bf16_t* up) {
    g2_pair<0>(tr_lo, tr_hi, bfr, uwv, bsp, up); g2_pair<1>(tr_lo, tr_hi, bfr, uwv, bsp, up); g2_pair<2>(tr_lo, tr_hi, bfr, uwv, bsp, up); g2_pair<3>(tr_lo, tr_hi, bfr, uwv, bsp, up);
    g2_pair<4>(tr_lo, tr_hi, bfr, uwv, bsp, up); g2_pair<5>(tr_lo, tr_hi, bfr, uwv, bsp, up); g2_pair<6>(tr_lo, tr_hi, bfr, uwv, bsp, up); g2_pair<7>(tr_lo, tr_hi, bfr, uwv, bsp, up);
    g2_pair<8>(tr_lo, tr_hi, bfr, uwv, bsp, up); g2_pair<9>(tr_lo, tr_hi, bfr, uwv, bsp, up); g2_pair<10>(tr_lo, tr_hi, bfr, uwv, bsp, up); g2_pair<11>(tr_lo, tr_hi, bfr, uwv, bsp, up);
}
__device__ __forceinline__ void phase_g2(bf16_t* U, const bf16_t* V, const float* vst, const float* lng, const float* lnb, const float* Ws, const float* bs, int nchunks, LAS unsigned char* lds, int vcu, int G, int tid, int wave, int lane) {
    asm volatile("" : "+v"(tid), "+v"(lane));
    constexpr int RPB = 784;
    LAS unsigned char* VR = lds;
    LAS float* mu = (LAS float*)(VR + 128 * RPB); LAS float* rsd = mu + 128; LAS float* gL = rsd + 128; LAS float* bL = gL + 384;
    const int NU = nchunks * 8;
    u32x4 vr[12];
#define G2_QE(i) const int blk_ = wave + 8 * (i), q = 8 * (blk_ & 15) + (lane >> 3), ep = 8 * (blk_ >> 4) + (lane & 7)
#define G2_LOADV(u) do { const int c_ = (u) >> 3, g_ = (u) & 7; \
        _Pragma("unroll") for (int i = 0; i < 12; ++i) { G2_QE(i); \
            vr[i] = *(const u32x4*)(V + (size_t)(128 * c_ + q) * EH + 384 * g_ + 8 * ep); } } while (0)
#define G2_BAR() do { asm volatile("s_waitcnt lgkmcnt(0)" ::: "memory"); __builtin_amdgcn_s_barrier(); asm volatile("" ::: "memory"); } while (0)
    int unit = vcu;
    if (unit < NU) G2_LOADV(unit);
    int gcur = -1; bf16x8 bfr[4]; float bsp = 0.f;
    const int p = 16 * wave + (lane & 15);
    const unsigned tr_lo = (unsigned)(size_t)VR + (unsigned)((8 * (lane >> 4) + ((lane & 15) >> 2)) * RPB + 8 * (lane & 3)), tr_hi = tr_lo + 64u * RPB;
    for (; unit < NU; unit += G) {
        const int c = unit >> 3, g = unit & 7, r0 = 128 * c, e0 = 384 * g;
        bf16_t* up = U + (size_t)(r0 + p) * EH + e0 + 8 * (lane >> 4);
        {
            const float* pq = vst + (size_t)(r0 + (tid >> 2)) * 96 + 4 * (tid & 3); f32x4 v[6];
#pragma unroll
            for (int i = 0; i < 6; ++i) v[i] = *(const f32x4*)(pq + 16 * i);
            if (g != gcur) {
                gcur = g;
                const float* wp = Ws + ((size_t)g * 128 + 16 * wave + (lane & 15)) * 128 + 8 * (lane >> 4);
#pragma unroll
                for (int ks = 0; ks < 4; ++ks) { const f32x4 w0 = *(const f32x4*)(wp + 32 * ks), w1 = *(const f32x4*)(wp + 32 * ks + 4);
                    u32x4 pk; pk.x = cvtpk(w0.x, w0.y); pk.y = cvtpk(w0.z, w0.w); pk.z = cvtpk(w1.x, w1.y); pk.w = cvtpk(w1.z, w1.w); bfr[ks] = __builtin_bit_cast(bf16x8, pk); }
                bsp = bs[g * 128 + p];
                if (tid < 96) *(LAS f32x4*)(gL + 4 * tid) = *(const f32x4*)(lng + e0 + 4 * tid); else if (tid < 192) *(LAS f32x4*)(bL + 4 * (tid - 96)) = *(const f32x4*)(lnb + e0 + 4 * (tid - 96));
            }
            float sm = 0.f, q = 0.f;
#pragma unroll
            for (int i = 0; i < 6; ++i) { sm += v[i].x + v[i].z; q += v[i].y + v[i].w; }
            sm += __shfl_xor(sm, 1); q += __shfl_xor(q, 1); sm += __shfl_xor(sm, 2); q += __shfl_xor(q, 2);
            if ((tid & 3) == 0) { const float m = sm * (1.0f / EH); const float var = fmaxf(q * (1.0f / EH) - m * m, 0.f); mu[tid >> 2] = m; rsd[tid >> 2] = 1.0f / sqrtf(var + EPS); } }
        u32x4 uwv[12];
#pragma unroll
        for (int i = 0; i < 12; ++i) uwv[i] = *(const u32x4*)(up + 32 * i);
        G2_BAR();
#pragma unroll
        for (int i = 0; i < 12; ++i) { G2_QE(i);
            const u32x4 w = vr[i];
            const f32x4 g0 = *(const LAS f32x4*)(gL + 8 * ep), g1 = *(const LAS f32x4*)(gL + 8 * ep + 4), b0 = *(const LAS f32x4*)(bL + 8 * ep), b1 = *(const LAS f32x4*)(bL + 8 * ep + 4);
            const float m = mu[q], rr = rsd[q];
            const f32x4 v0 = {bflo(w.x), bfhi(w.x), bflo(w.y), bfhi(w.y)}, v1 = {bflo(w.z), bfhi(w.z), bflo(w.w), bfhi(w.w)};
            const f32x4 o0 = (v0 - m) * rr * g0 + b0, o1 = (v1 - m) * rr * g1 + b1;
            LAS unsigned char* dst = VR + q * RPB + (32 * (ep >> 2) + 4 * (ep & 3)) * 2;
            u32x2 lo, hi; lo.x = cvtpk(o0.x, o0.y); lo.y = cvtpk(o0.z, o0.w); hi.x = cvtpk(o1.x, o1.y); hi.y = cvtpk(o1.z, o1.w);
            *(LAS u32x2*)dst = lo; *(LAS u32x2*)(dst + 32) = hi; }
        { const int nu = unit + G; if (nu < NU) G2_LOADV(nu); }
        G2_BAR();
        g2_pairs(tr_lo, tr_hi, bfr, uwv, bsp, up);
        G2_BAR();
    }
    __syncthreads();
#undef G2_QE
#undef G2_LOADV
#undef G2_BAR
}


#ifndef MK_PER_PHASE
#define MK_PER_PHASE 0
#endif
constexpr int N_STEPS = 2 + 8 * 3 + 2 * 8 + 2 * 4;
struct Args { const float* in[26]; float* out; unsigned char* ws; int ph_lo, ph_hi, mode, pad; };

constexpr int CV_L0 = 0, CV_L1 = 5760, CV_L2 = 12288, CV_L3 = 18048, CV_END = 24576;
#define CONV_ITEM(idx_, scr_) do { const int ix_ = (idx_); const int l_ = (ix_ < CV_L1) ? 0 : (ix_ < CV_L2) ? 1 : (ix_ < CV_L3) ? 2 : 3; \
        int of_ = ix_ - ((l_ == 0) ? CV_L0 : (l_ == 1) ? CV_L1 : (l_ == 2) ? CV_L2 : CV_L3); int f_ = 0; \
        const int msz_ = (l_ & 1) ? 2304 : 1536; \
        if (of_ >= 2112 + msz_) { of_ -= 2112 + msz_; f_ = 1; } \
        if (of_ < 1408) p0_transpose_item(INP(7) + (size_t)(l_ * 2 + f_) * D * 2 * DFF, D, 2 * DFF, WFI + (size_t)(l_ * 2 + f_) * 2 * DFF * D, 1, (scr_), of_, lane, 0); \
        else if (of_ < 2112) p0_transpose_item(INP(8) + (size_t)(l_ * 2 + f_) * DFF * D, DFF, D, WFO + (size_t)(l_ * 2 + f_) * D * DFF, 0, (scr_), of_ - 1408, lane, 0); \
        else { of_ -= 2112; const int m_ = l_ >> 1; \
            if (!(l_ & 1)) { if (of_ < 1024) p0_transpose_item(INP(9) + (size_t)m_ * D * 2 * DI, D, 2 * DI, WAI + (size_t)m_ * 2 * DI * D, 0, (scr_), of_, lane, 0); \
                             else p0_transpose_item(INP(17) + (size_t)m_ * DI * D, DI, D, WAO + (size_t)m_ * D * DI, 0, (scr_), of_ - 1024, lane, 0); } \
            else { if (of_ < 1536) p0_transpose_item(INP(18) + (size_t)m_ * D * 2 * EH, D, 2 * EH, WBI + (size_t)m_ * 2 * EH * D, 0, (scr_), of_, lane, 0); \
                   else p0_transpose_item(INP(24) + (size_t)m_ * EH * D, EH, D, WBO + (size_t)m_ * D * EH, 0, (scr_), of_ - 1536, lane, 0); } } } while (0)
#define BG_CONVERT(cb_, ce_, i0_) do { unsigned char* const ws = WSB; LAS float* scr_b = (LAS float*)(lds + wave * 16640); \
        const int nw_ = (G - (i0_)) * NWAVES, q_ = ((ce_) - (cb_) + nw_ - 1) / nw_, w_ = (bx - (i0_)) * NWAVES + wave; \
        for (int qi_ = 0; qi_ < q_; ++qi_) { const int id_ = (cb_) + w_ * q_ + qi_; if (id_ < (ce_)) CONV_ITEM(id_, scr_b); } __syncthreads(); } while (0)

__device__ __forceinline__ int mk_lane() { unsigned z = 0; asm volatile("" : "+v"(z)); return (int)__builtin_amdgcn_mbcnt_hi(~0u, __builtin_amdgcn_mbcnt_lo(~0u, z)); }
__global__ void __launch_bounds__(NTHREADS, 2) mk_fwd(Args args) {
    extern __shared__ __attribute__((aligned(16))) unsigned char lds_raw[];
    LAS unsigned char* lds = (LAS unsigned char*)lds_raw;
    const int wave = __builtin_amdgcn_readfirstlane((int)threadIdx.x >> 6);
#define lane mk_lane()
#define tid (wave * 64 + mk_lane())
    const int G = gridDim.x; const int bx = blockIdx.x; const int vcu = (G % 8 == 0) ? (bx % 8) * (G / 8) + bx / 8 : bx;
    const int gw = vcu * NWAVES + wave, NGW = G * NWAVES;
    LAS unsigned long long* PT = (LAS unsigned long long*)(lds + LDSCTL_OFF + 1024);
    for (int u = tid; u < (LDS_BYTES - LDSCTL_OFF) / 4; u += NTHREADS) ((LAS unsigned*)(lds + LDSCTL_OFF))[u] = 0u;
    __syncthreads();
    if (tid == 0) {
#define PT_SET(i) PT[i] = (unsigned long long)args.in[i];
        PT_SET(0) PT_SET(1) PT_SET(2) PT_SET(3) PT_SET(4) PT_SET(5) PT_SET(6) PT_SET(7) PT_SET(8) PT_SET(9) PT_SET(10) PT_SET(11) PT_SET(12) PT_SET(13)
        PT_SET(14) PT_SET(15) PT_SET(16) PT_SET(17) PT_SET(18) PT_SET(19) PT_SET(20) PT_SET(21) PT_SET(22) PT_SET(23) PT_SET(24) PT_SET(25)
#undef PT_SET
        PT[26] = (unsigned long long)args.out; PT[27] = (unsigned long long)args.ws;
    }
    __syncthreads();
    const int lo = args.ph_lo, hi = args.ph_hi;
    if (hi - lo > 1) (void)xcd_barrier_post((unsigned*)(args.ws + WS_CTL) + CW_BAR, (volatile LAS unsigned*)(lds + MISC_OFF) + 8);
#define PTRU(i) ((unsigned long long)(unsigned)__builtin_amdgcn_readfirstlane((int)(unsigned)(PT[i] & 0xffffffffull)) | ((unsigned long long)(unsigned)__builtin_amdgcn_readfirstlane((int)(unsigned)(PT[i] >> 32)) << 32))
#define INP(i) ((const float*)(const GAS float*)PTRU(i))
#define WSB ((unsigned char*)(GAS unsigned char*)PTRU(27))
#define x_in INP(0)
#define c_in INP(1)
#define ctx_in INP(2)
#define cctx_in INP(3)
#define w_ada INP(4)
#define b_ada INP(5)
#define normg INP(6)
#define X ((float*)(GAS float*)PTRU(26))
#define CTXS ((float*)(ws + WS_CTXS))
#define MOD ((float*)(ws + WS_MOD))
#define XN ((bf16_t*)(ws + WS_XN))
#define Y ((bf16_t*)(ws + WS_Y))
#define WFI ((bf16_t*)(ws + WS_WFI))
#define WFO ((bf16_t*)(ws + WS_WFO))
#define WAI ((bf16_t*)(ws + WS_WAI))
#define WAO ((bf16_t*)(ws + WS_WAO))
#define WBI ((bf16_t*)(ws + WS_WBI))
#define WBO ((bf16_t*)(ws + WS_WBO))
#define WCM ((bf16_t*)(ws + WS_WCM))

    int step = 0;
#define RUN (step >= lo && step < hi)
#define ENDSTEP do { if (RUN && step + 1 < hi) { XcdBarrier bar_; bar_.bar = (unsigned*)((GAS unsigned char*)PTRU(27) + WS_CTL) + CW_BAR; bar_.x = xb_xcc_id(); bar_.st = (volatile LAS unsigned*)(lds + MISC_OFF) + 8; xcd_barrier(bar_); } ++step; } while (0)

    if (RUN) { unsigned char* const ws = WSB;
        if (vcu < 144 && !(args.mode & 4)) adaln_unit(c_in, cctx_in, w_ada, b_ada, MOD, lds, vcu, tid, wave, lane);
        for (int i = vcu * NTHREADS + tid; i < 2 * 2048 * 16; i += G * NTHREADS) wcm_item(INP(12), INP(13), WCM, i);
        const int p0_end = (G == 256) ? CV_L1 : CV_END;
#define P0_IDX(v_) (v_)
        unsigned* qctr = (unsigned*)(ws + WS_CTL) + 64 + 32 * (args.mode >> 8);
        LAS float* scr = (LAS float*)(lds + wave * 16640);
        volatile LAS unsigned* qslot = (volatile LAS unsigned*)(lds + MISC_OFF) + 16;
        for (;;) {
            __syncthreads();
            if (tid == 0) qslot[0] = __hip_atomic_fetch_add(qctr, 16u, __ATOMIC_RELAXED, __HIP_MEMORY_SCOPE_AGENT);
            __syncthreads();
            const int base = (int)qslot[0];
            if (base >= p0_end) break;
            for (int sub = 0; sub < 2; ++sub) { const int it = base + 2 * wave + sub; if (it < p0_end) CONV_ITEM(P0_IDX(it), scr); }
        }
        __syncthreads();
    }
    ENDSTEP;
    if (RUN) { unsigned char* const ws = WSB; const ThinP p{1, 0, 0, 0, 0, 0.f, 1, 0, 0, 0, 1}; thin_phase(p, x_in, ctx_in, (const bf16_t*)X, (bf16_t*)X, X, CTXS, Y, (const float*)(ws + WS_YCP), 0, XN, MOD, normg, gw, NGW, lane); }
    ENDSTEP;

#pragma unroll 1
    for (int sb = 0; sb < 12; ++sb) {
        const int layer = sb / 3, sub = sb % 3, li = layer >> 1;
        const int kind = (sub != 1) ? 0 : ((layer & 1) ? 2 : 1);
        const int f = sub >> 1;
        const bool cin = (kind == 0) ? ((sub == 0) ? (layer <= 2) : (layer <= 1)) : (kind == 1) ? true : (layer <= 1);
        const bool cout = (kind == 0) ? cin : (layer <= 1);
        const int Min = cin ? R : ML;
        if (kind == 0) {
            if (RUN) { unsigned char* const ws = WSB; pg8::Gemm g{XN, WFI + (size_t)(layer * 2 + f) * 2 * DFF * D, Min, 2 * DFF, D, D}; pg8::StaticOrder S; S.init(Min, 2 * DFF, G, bx);
                EpiSwiGLU E{(bf16_t*)(ws + WS_H), DFF}; pg8::gemm_phase<EpiSwiGLU, pg8::StaticOrder, PG8_ALIGN, PG8_SP2>(lds, g, S, E);
            }
            ENDSTEP;
        } else if (kind == 1) {
            if (RUN) { unsigned char* const ws = WSB; pg8::Gemm g{XN, WAI + (size_t)li * 2 * DI * D, R, 2 * DI, D, D}; pg8::StaticOrder S; S.init(R, 2 * DI, G, bx);
                pg8::EpiBf16<0> E{(bf16_t*)(ws + WS_XM), DI, nullptr, DI, (size_t)(WS_Z - WS_XM) / 2, 1.f}; pg8::gemm_phase<pg8::EpiBf16<0>, pg8::StaticOrder, PG8_ALIGN, PG8_SP2>(lds, g, S, E);
                if (G == 256 && bx >= 32) { if (layer == 0) BG_CONVERT(CV_L1, CV_L2, 32); else BG_CONVERT(CV_L3, CV_END, 32); } }
            ENDSTEP;
            if (RUN) { unsigned char* const ws = WSB; phase_a2((const bf16_t*)(ws + WS_XM), (bf16_t*)(ws + WS_XC), (bf16_t*)(ws + WS_Q), (bf16_t*)(ws + WS_K), (bf16_t*)(ws + WS_VV),
                              INP(10) + (size_t)li * 9 * DI, INP(11) + (size_t)li * DI, INP(12) + (size_t)li * 3 * 512 * 16, vcu, G, wave, lane); }
            ENDSTEP;
            if (RUN) { unsigned char* const ws = WSB;
                phase_a3((bf16_t*)(ws + WS_Q), (bf16_t*)(ws + WS_K), (bf16_t*)(ws + WS_VV), (bf16_t*)(ws + WS_SRAW), (const bf16_t*)(ws + WS_XC), (const bf16_t*)(ws + WS_XM), WCM + (size_t)li * 128 * 512, INP(14) + li * 16,
                         (float*)(ws + WS_GATES), lds, vcu, G, tid, wave, lane);
            }
            ENDSTEP;
            if (RUN) { unsigned char* const ws = WSB; if (G == 256) phase_a3bc((const float*)(ws + WS_GATES), (const bf16_t*)(ws + WS_SRAW), (bf16_t*)(ws + WS_SDT), (float*)(ws + WS_TAB), (float*)(ws + WS_GM), lds, vcu, tid, wave, lane); }
            ENDSTEP;
            if (RUN) { unsigned char* const ws = WSB; if (G == 256) phase_a4((const bf16_t*)(ws + WS_Q), (const bf16_t*)(ws + WS_K), (const bf16_t*)(ws + WS_VV), (const bf16_t*)(ws + WS_SDT), (const float*)(ws + WS_TAB),
                                (bf16_t*)(ws + WS_NUMF), (bf16_t*)(ws + WS_NUMB), (float*)(ws + WS_PD), lds, vcu, tid, wave, lane); }
            ENDSTEP;
            if (RUN) { unsigned char* const ws = WSB; phase_a5((const bf16_t*)(ws + WS_NUMF), (const bf16_t*)(ws + WS_NUMB), (const float*)(ws + WS_PD), (const float*)(ws + WS_GM), (const bf16_t*)(ws + WS_XC), (const bf16_t*)(ws + WS_Z),
                              (bf16_t*)(ws + WS_G), INP(15) + (size_t)li * DI, INP(16) + (size_t)li * DI, cout ? R : ML, gw, NGW, lane); }
            ENDSTEP;
        } else {
            if (RUN) { unsigned char* const ws = WSB; pg8::Gemm g{XN, WBI + (size_t)li * 2 * EH * D, Min, 2 * EH, D, D}; pg8::StaticOrder S; S.init(Min, 2 * EH, G, bx);
                EpiGeluUV E{(bf16_t*)(ws + WS_U), (bf16_t*)(ws + WS_V), INP(19) + (size_t)li * 2 * EH, (float*)(ws + WS_VST)}; pg8::gemm_phase<EpiGeluUV, pg8::StaticOrder, PG8_ALIGN, PG8_SP2>(lds, g, S, E);
                if (G == 256 && layer == 1 && bx >= 48) BG_CONVERT(CV_L2, CV_L3, 48); }
            ENDSTEP;
            if (RUN) { unsigned char* const ws = WSB; phase_g2((bf16_t*)(ws + WS_U), (const bf16_t*)(ws + WS_V), (const float*)(ws + WS_VST), INP(20) + (size_t)li * EH, INP(21) + (size_t)li * EH,
                              INP(22) + (size_t)li * 8 * 128 * 128, INP(23) + (size_t)li * 8 * 128, Min / 128, lds, vcu, G, tid, wave, lane); }
            ENDSTEP;
        }
#define OUT_GEMM(Aexpr, Btexpr, KK, biasexpr) do { unsigned char* const ws = WSB; pg8::Gemm g{(Aexpr), (Btexpr), R, D, (KK), (KK)}; OutOrder S; S.init(cout ? (KK) : 0, G, bx); \
            EpiOut E{Y, (float*)(ws + WS_YCP), (biasexpr)}; pg8::gemm_phase<EpiOut, OutOrder, PG8_ALIGN, PG8_SP2>(lds, g, S, E); } while (0)
        if (kind == 0) { if (RUN) OUT_GEMM((const bf16_t*)(ws + WS_H), WFO + (size_t)(layer * 2 + f) * D * DFF, DFF, (const float*)nullptr); }
        else if (kind == 1) { if (RUN) OUT_GEMM((const bf16_t*)(ws + WS_G), WAO + (size_t)li * D * DI, DI, (const float*)nullptr); }
        else { if (RUN) OUT_GEMM((const bf16_t*)(ws + WS_U), WBO + (size_t)li * D * EH, EH, INP(25) + (size_t)li * D); }
#undef OUT_GEMM
        ENDSTEP;
        if (RUN) { unsigned char* const ws = WSB;
            ThinP p;
            p.first = (sb == 0) ? 1 : 0; p.has_y = 1; p.lp = layer;
            if (sub == 0) { p.gate_i = 2; p.gpost_i = 1; p.wgt = 0.5f; p.has_next = 1; p.ln = layer; p.gpre_i = 2; p.shift_i = 3; p.scale_i = 4; }
            else if (sub == 1) { p.gate_i = 5; p.gpost_i = 3; p.wgt = 1.0f; p.has_next = 1; p.ln = layer; p.gpre_i = 4; p.shift_i = 6; p.scale_i = 7; }
            else { p.gate_i = 8; p.gpost_i = 5; p.wgt = 0.5f; p.has_next = (layer < DEPTH - 1) ? 1 : 0; p.ln = (layer < DEPTH - 1) ? layer + 1 : layer; p.gpre_i = 0; p.shift_i = 0; p.scale_i = 1; }
            const bf16_t* xr_ = (sb == 11) ? (const bf16_t*)(ws + WS_XALT) : (const bf16_t*)X; bf16_t* xw_ = (sb == 10) ? (bf16_t*)(ws + WS_XALT) : (bf16_t*)X;
            thin_phase(p, x_in, ctx_in, xr_, xw_, X, CTXS, Y, (const float*)(ws + WS_YCP), !cout ? -1 : (kind == 0) ? DFF / 256 : (kind == 1) ? DI / 256 : EH / 256, XN, MOD, normg, gw, NGW, lane);
        }
        ENDSTEP;
    }
#undef RUN
#undef lane
#undef tid
#undef ENDSTEP
#undef x_in
#undef c_in
#undef ctx_in
#undef cctx_in
#undef w_ada
#undef b_ada
#undef normg
#undef X
#undef CTXS
#undef MOD
#undef XN
#undef Y
#undef WFI
#undef WFO
#undef WAI
#undef WAO
#undef WBI
#undef WBO
#undef WCM
}
}

extern "C" void kernel_launch(void* const* d_in, const int* in_sizes, int n_in, void* d_out, int out_size, void* d_ws, size_t ws_size, hipStream_t stream) {
    using namespace mk;
    static int grid = 0;
    if (grid == 0) {
        if (n_in != 26 || out_size != ML * D || ws_size < WS_END) { fprintf(stderr, "kernel_launch: unexpected shapes (n_in %d, out %d, ws %zu < %zu); nothing launched\n", n_in, out_size, ws_size, (size_t)WS_END); grid = -1; return; }
        int dev = 0, cus = 0, per_cu = 0;
        if (hipGetDevice(&dev) != hipSuccess || hipDeviceGetAttribute(&cus, hipDeviceAttributeMultiprocessorCount, dev) != hipSuccess) { grid = -1; return; }
        if (hipFuncSetAttribute((const void*)mk_fwd, hipFuncAttributeMaxDynamicSharedMemorySize, LDS_BYTES) != hipSuccess) { fprintf(stderr, "kernel_launch: hipFuncSetAttribute failed\n"); grid = -1; return; }
        if (hipOccupancyMaxActiveBlocksPerMultiprocessor(&per_cu, (const void*)mk_fwd, NTHREADS, LDS_BYTES) != hipSuccess || per_cu < 1) { fprintf(stderr, "kernel_launch: occupancy query says %d\n", per_cu); }
        (void)hipGetLastError();
        grid = cus;
        if (grid != 256) { fprintf(stderr, "kernel_launch: this kernel is built for 256 CUs, found %d\n", grid); }
    }
    if (grid < 0) return;
    (void)hipMemsetAsync((char*)d_ws + WS_CTL, 0, CTL_ZERO_BYTES, stream);
    Args a{};
    for (int i = 0; i < 26; ++i) a.in[i] = (const float*)d_in[i];
    a.out = (float*)d_out; a.ws = (unsigned char*)d_ws;
#if MK_PER_PHASE
    for (int s = 0; s < N_STEPS; ++s) { a.ph_lo = s; a.ph_hi = s + 1; hipLaunchKernelGGL(mk_fwd, dim3(grid), dim3(NTHREADS), LDS_BYTES, stream, a); }
#else
    a.ph_lo = 0; a.ph_hi = N_STEPS; hipLaunchKernelGGL(mk_fwd, dim3(grid), dim3(NTHREADS), LDS_BYTES, stream, a);
#endif
#ifdef MK_PROBE_STEP
#ifdef MK_PROBE_MODE
    a.mode = MK_PROBE_MODE;
#endif
    for (int rep = 0; rep < MK_PROBE_REP; ++rep) { a.mode = (a.mode & 255) | ((rep + 1) << 8); a.ph_lo = MK_PROBE_STEP; a.ph_hi = MK_PROBE_STEP + 1; hipLaunchKernelGGL(mk_fwd, dim3(grid), dim3(NTHREADS), LDS_BYTES, stream, a); }
#endif
}
```
